# Optimizing an MI355X kernel written in HIP

```python
import jax, jax.numpy as jnp
from jax import lax
import numpy as np

D_MODEL = 2048
BATCH = 2
SEQ = 16384
DEPTH = 2

LRU_WIDTH = D_MODEL // 2
LRU_BLOCKS = 8
CONV_WIDTH = 4
LRU_C = 8.0
SB_HEADS = 8
SB_WIDTH = D_MODEL // 2
SB_HEAD_DIM = SB_WIDTH // SB_HEADS
Q_BLOCK = 128
RET_HEADS = 8
RET_QK_DIM = D_MODEL // RET_HEADS
RET_V_DIM = 2 * D_MODEL // RET_HEADS
RET_CHUNK = 128
ROPE_BASE = 10000.0
MOE_GROUPS = 4
MOE_EXPERTS_PER_GROUP = 8
MOE_EXPERTS = MOE_GROUPS * MOE_EXPERTS_PER_GROUP
MOE_TOP_K = 2
EXPERT_FF = 512
MOE_BLOCK = 128
EPS = 1e-6

EVEN_IN = 2 * LRU_WIDTH + 3 * SB_WIDTH
EVEN_SPLITS = [LRU_WIDTH, 2 * LRU_WIDTH, 2 * LRU_WIDTH + SB_WIDTH, 2 * LRU_WIDTH + 2 * SB_WIDTH]
ODD_QK = RET_HEADS * RET_QK_DIM
ODD_V = RET_HEADS * RET_V_DIM
ODD_IN = 2 * ODD_QK + 2 * ODD_V
ODD_SPLITS = [ODD_QK, 2 * ODD_QK, 2 * ODD_QK + ODD_V]

kernel_name = "hybrid_rglru_stickbreak_retention_hmoe"


def rms_norm(x, g):
    xf = x.astype(jnp.float32)
    y = xf * lax.rsqrt(jnp.mean(xf * xf, axis=-1, keepdims=True) + EPS)
    return (y * g.astype(jnp.float32)).astype(x.dtype)


def causal_depthwise_conv(x, w, b):
    S = x.shape[1]
    xp = jnp.pad(x, ((0, 0), (CONV_WIDTH - 1, 0), (0, 0)))
    return b + sum(w[k] * xp[:, k:k + S] for k in range(CONV_WIDTH))


def rg_lru(x, ga_w, ga_b, gx_w, gx_b, lam):
    B, S, C = x.shape
    xf = x.astype(jnp.float32)
    xb = xf.reshape(B, S, LRU_BLOCKS, C // LRU_BLOCKS)
    r = jax.nn.sigmoid(jnp.einsum('bsgi,gij->bsgj', xb, ga_w.astype(jnp.float32)) + ga_b).reshape(B, S, C)
    i = jax.nn.sigmoid(jnp.einsum('bsgi,gij->bsgj', xb, gx_w.astype(jnp.float32)) + gx_b).reshape(B, S, C)
    log_a = -LRU_C * r * jax.nn.softplus(-lam.astype(jnp.float32))
    a = jnp.exp(log_a)
    u = jnp.sqrt(-jnp.expm1(2.0 * log_a)) * (i * xf)

    def combine(left, right):
        a1, b1 = left
        a2, b2 = right
        return a1 * a2, a2 * b1 + b2

    _, h = lax.associative_scan(combine, (a, u), axis=1)
    return h


def stick_breaking_attention(q, k, v):
    B, S, H, dh = q.shape
    nq = S // Q_BLOCK
    scale = dh ** -0.5
    qb = jnp.moveaxis(q.reshape(B, nq, Q_BLOCK, H, dh), 1, 0)
    kf = k.astype(jnp.float32)
    vf = v.astype(jnp.float32)
    key_pos = jnp.arange(S, dtype=jnp.int32)

    def block(args):
        q_blk, blk = args
        z = jnp.einsum('bqhd,bkhd->bhqk', q_blk.astype(jnp.float32), kf) * scale
        q_pos = blk * Q_BLOCK + jnp.arange(Q_BLOCK, dtype=jnp.int32)
        causal = key_pos[None, :] < q_pos[:, None]
        log_beta = jax.nn.log_sigmoid(z)
        log_1m = jnp.where(causal, log_beta - z, 0.0)
        log_rest = lax.cumsum(log_1m, axis=3, reverse=True) - log_1m
        w = jnp.where(causal, jnp.exp(log_beta + log_rest), 0.0)
        return jnp.einsum('bhqk,bkhd->bqhd', w, vf)

    o = lax.map(block, (qb, jnp.arange(nq, dtype=jnp.int32)))
    return jnp.moveaxis(o, 0, 1).reshape(B, S, H * dh)


def rotary(x, pos):
    half = x.shape[-1] // 2
    inv_freq = ROPE_BASE ** (-jnp.arange(half, dtype=jnp.float32) / half)
    ang = pos.astype(jnp.float32)[..., None] * inv_freq
    cos = jnp.cos(ang)[:, :, None, :]
    sin = jnp.sin(ang)[:, :, None, :]
    x1, x2 = x[..., :half], x[..., half:]
    return jnp.concatenate([x1 * cos - x2 * sin, x2 * cos + x1 * sin], axis=-1)


def chunkwise_retention(q, k, v, positions):
    B, S, H, dk = q.shape
    dv = v.shape[-1]
    C = RET_CHUNK
    N = S // C
    q = rotary(q.astype(jnp.float32), positions)
    k = rotary(k.astype(jnp.float32), positions) * (dk ** -0.5)
    v = v.astype(jnp.float32)
    log_g = jnp.log1p(-jnp.power(2.0, -5.0 - jnp.arange(H, dtype=jnp.float32)))
    c = jnp.arange(C, dtype=jnp.float32)
    diff = c[:, None] - c[None, :]
    intra_decay = jnp.where(diff >= 0, jnp.exp(jnp.maximum(diff, 0.0)[None] * log_g[:, None, None]), 0.0)
    q_decay = jnp.exp((c + 1.0)[:, None] * log_g)
    k_decay = jnp.exp((C - 1.0 - c)[:, None] * log_g)
    chunk_decay = jnp.exp(C * log_g)

    qc = q.reshape(B, N, C, H, dk)
    kc = k.reshape(B, N, C, H, dk)
    vc = v.reshape(B, N, C, H, dv)
    s = jnp.einsum('bnchd,bnmhd->bnhcm', qc, kc) * intra_decay
    intra = jnp.einsum('bnhcm,bnmhe->bnche', s, vc)

    def step(R, xs):
        q_n, k_n, v_n = xs
        out = jnp.einsum('bchd,bhde->bche', q_n * q_decay[:, :, None], R)
        R = R * chunk_decay[:, None, None] + jnp.einsum('bchd,bche->bhde', k_n * k_decay[:, :, None], v_n)
        return R, out

    R0 = jnp.zeros((B, H, dk, dv), jnp.float32)
    _, cross = lax.scan(step, R0, (jnp.moveaxis(qc, 1, 0), jnp.moveaxis(kc, 1, 0), jnp.moveaxis(vc, 1, 0)))
    y = intra + jnp.moveaxis(cross, 0, 1)
    return y.reshape(B, S, H, dv)


def head_group_norm(y, gain):
    mu = jnp.mean(y, axis=-1, keepdims=True)
    yc = y - mu
    var = jnp.mean(yc * yc, axis=-1, keepdims=True)
    return yc * lax.rsqrt(var + EPS) * gain.astype(jnp.float32)


def even_mixer(h, w_in, conv_w, conv_b, ga_w, ga_b, gx_w, gx_b, lam, w_out):
    B, S, _ = h.shape
    proj = h @ w_in
    xr, gr, q, k, v = jnp.split(proj, EVEN_SPLITS, axis=-1)
    xr = causal_depthwise_conv(xr, conv_w, conv_b)
    y_a = rg_lru(xr, ga_w, ga_b, gx_w, gx_b, lam) * jax.nn.gelu(gr.astype(jnp.float32))
    shp = (B, S, SB_HEADS, SB_HEAD_DIM)
    y_b = stick_breaking_attention(q.reshape(shp), k.reshape(shp), v.reshape(shp))
    y = jnp.concatenate([y_a, y_b], axis=-1).astype(h.dtype)
    return y @ w_out


def odd_mixer(h, positions, w_in, gn_gain, w_out):
    B, S, _ = h.shape
    proj = h @ w_in
    q, k, v, g = jnp.split(proj, ODD_SPLITS, axis=-1)
    y = chunkwise_retention(q.reshape(B, S, RET_HEADS, RET_QK_DIM), k.reshape(B, S, RET_HEADS, RET_QK_DIM),
                            v.reshape(B, S, RET_HEADS, RET_V_DIM), positions)
    y = head_group_norm(y, gn_gain).reshape(B, S, ODD_V)
    y = jax.nn.silu(g.astype(jnp.float32)) * y
    return y.astype(h.dtype) @ w_out


def hierarchical_moe(h, wg, bg, we, be, w_gate, w_up, w_down):
    B, S, D = h.shape
    T = B * S
    xf = h.reshape(T, D)
    g_logits = (xf @ wg + bg).astype(jnp.float32)
    g_prob = jax.nn.softmax(g_logits, axis=-1)
    g_idx = jnp.argmax(g_logits, axis=-1).astype(jnp.int32)
    g_w = jnp.take_along_axis(g_prob, g_idx[:, None], axis=-1)
    e_logits = (xf @ we + be).astype(jnp.float32).reshape(T, MOE_GROUPS, MOE_EXPERTS_PER_GROUP)
    e_sel = jnp.take_along_axis(e_logits, g_idx[:, None, None], axis=1)[:, 0]
    top_p, top_j = lax.top_k(jax.nn.softmax(e_sel, axis=-1), MOE_TOP_K)
    top_w = top_p / jnp.sum(top_p, axis=-1, keepdims=True) * g_w
    expert = g_idx[:, None] * MOE_EXPERTS_PER_GROUP + top_j.astype(jnp.int32)

    A = T * MOE_TOP_K
    e_flat = expert.reshape(A)
    w_flat = top_w.reshape(A)
    tok_flat = jnp.repeat(jnp.arange(T, dtype=jnp.int32), MOE_TOP_K)
    order = jnp.argsort(e_flat)
    e_sorted = e_flat[order]
    tok_sorted = tok_flat[order]
    w_sorted = w_flat[order]
    counts = jnp.bincount(e_flat, length=MOE_EXPERTS).astype(jnp.int32)
    starts = jnp.cumsum(counts) - counts
    padded = ((counts + MOE_BLOCK - 1) // MOE_BLOCK) * MOE_BLOCK
    pends = jnp.cumsum(padded)
    pstarts = pends - padded
    dest = pstarts[e_sorted] + (jnp.arange(A, dtype=jnp.int32) - starts[e_sorted])
    P = A + MOE_EXPERTS * MOE_BLOCK
    nb = P // MOE_BLOCK
    row_tok = jnp.zeros((P,), jnp.int32).at[dest].set(tok_sorted)
    x_rows = xf[row_tok].reshape(nb, MOE_BLOCK, D)
    blk_expert = jnp.clip(jnp.searchsorted(pends, jnp.arange(nb, dtype=jnp.int32) * MOE_BLOCK, side='right'),
                          0, MOE_EXPERTS - 1).astype(jnp.int32)

    def expert_block(args):
        xb, e = args
        return (jax.nn.silu(xb @ w_gate[e]) * (xb @ w_up[e])) @ w_down[e]

    y_rows = lax.map(expert_block, (x_rows, blk_expert)).reshape(P, D)
    y = y_rows[dest] * w_sorted[:, None].astype(y_rows.dtype)
    out = jax.ops.segment_sum(y, tok_sorted, num_segments=T)
    return out.reshape(B, S, D)


def setup_inputs(seed: int = 0) -> dict:
    key = jax.random.key(seed)
    ks = iter(jax.random.split(key, 40))
    n_even = (DEPTH + 1) // 2
    n_odd = DEPTH // 2
    f32 = jnp.float32

    def nrm(shape, scale):
        return jax.random.normal(next(ks), shape, f32) * scale

    def gain(shape):
        return 1.0 + 0.02 * jax.random.normal(next(ks), shape, f32)

    x = jax.random.normal(next(ks), (BATCH, SEQ, D_MODEL), f32)
    offsets = jax.random.randint(next(ks), (BATCH,), 0, 4096, dtype=jnp.int32)
    positions = offsets[:, None] + jnp.arange(SEQ, dtype=jnp.int32)[None, :]
    blk = LRU_WIDTH // LRU_BLOCKS
    u = jax.random.uniform(next(ks), (n_even, LRU_WIDTH), f32, minval=0.9, maxval=0.999)
    a0 = u ** (1.0 / LRU_C)
    lam = jnp.log(a0) - jnp.log1p(-a0)
    return {
        "x": x,
        "positions": positions,
        "ev_norm": gain((n_even, D_MODEL)),
        "ev_w_in": nrm((n_even, D_MODEL, EVEN_IN), D_MODEL ** -0.5),
        "ev_conv_w": nrm((n_even, CONV_WIDTH, LRU_WIDTH), CONV_WIDTH ** -0.5),
        "ev_conv_b": nrm((n_even, LRU_WIDTH), 0.01),
        "ev_gate_a_w": nrm((n_even, LRU_BLOCKS, blk, blk), blk ** -0.5),
        "ev_gate_a_b": nrm((n_even, LRU_BLOCKS, blk), 0.01),
        "ev_gate_x_w": nrm((n_even, LRU_BLOCKS, blk, blk), blk ** -0.5),
        "ev_gate_x_b": nrm((n_even, LRU_BLOCKS, blk), 0.01),
        "ev_lru_lambda": lam,
        "ev_w_out": nrm((n_even, LRU_WIDTH + SB_WIDTH, D_MODEL), (LRU_WIDTH + SB_WIDTH) ** -0.5),
        "od_norm": gain((n_odd, D_MODEL)),
        "od_w_in": nrm((n_odd, D_MODEL, ODD_IN), D_MODEL ** -0.5),
        "od_gn_gain": gain((n_odd, RET_HEADS, RET_V_DIM)),
        "od_w_out": nrm((n_odd, ODD_V, D_MODEL), ODD_V ** -0.5),
        "ffn_norm": gain((DEPTH, D_MODEL)),
        "router_group_w": nrm((DEPTH, D_MODEL, MOE_GROUPS), D_MODEL ** -0.5),
        "router_group_b": nrm((DEPTH, MOE_GROUPS), 0.01),
        "router_expert_w": nrm((DEPTH, D_MODEL, MOE_EXPERTS), D_MODEL ** -0.5),
        "router_expert_b": nrm((DEPTH, MOE_EXPERTS), 0.01),
        "expert_w_gate": nrm((DEPTH, MOE_EXPERTS, D_MODEL, EXPERT_FF), D_MODEL ** -0.5),
        "expert_w_up": nrm((DEPTH, MOE_EXPERTS, D_MODEL, EXPERT_FF), D_MODEL ** -0.5),
        "expert_w_down": nrm((DEPTH, MOE_EXPERTS, EXPERT_FF, D_MODEL), EXPERT_FF ** -0.5),
        "final_norm": gain((D_MODEL,)),
    }


def reference(x, positions, ev_norm, ev_w_in, ev_conv_w, ev_conv_b, ev_gate_a_w, ev_gate_a_b,
              ev_gate_x_w, ev_gate_x_b, ev_lru_lambda, ev_w_out, od_norm, od_w_in, od_gn_gain,
              od_w_out, ffn_norm, router_group_w, router_group_b, router_expert_w, router_expert_b,
              expert_w_gate, expert_w_up, expert_w_down, final_norm):
    for layer in range(DEPTH):
        i = layer // 2
        if layer % 2 == 0:
            h = rms_norm(x, ev_norm[i])
            x = x + even_mixer(h, ev_w_in[i], ev_conv_w[i], ev_conv_b[i], ev_gate_a_w[i], ev_gate_a_b[i],
                               ev_gate_x_w[i], ev_gate_x_b[i], ev_lru_lambda[i], ev_w_out[i])
        else:
            h = rms_norm(x, od_norm[i])
            x = x + odd_mixer(h, positions, od_w_in[i], od_gn_gain[i], od_w_out[i])
        h = rms_norm(x, ffn_norm[layer])
        x = x + hierarchical_moe(h, router_group_w[layer], router_group_b[layer], router_expert_w[layer],
                                 router_expert_b[layer], expert_w_gate[layer], expert_w_up[layer],
                                 expert_w_down[layer])
    return rms_norm(x, final_norm)
```

```cpp
#include <hip/hip_runtime.h>
#include <cstdio>
#include <cstdint>
#include <cstring>

#define LAS __attribute__((address_space(3)))
#define GAS __attribute__((address_space(1)))
typedef unsigned short bf16_t;
typedef short bf16x8 __attribute__((ext_vector_type(8)));
typedef float f32x4 __attribute__((ext_vector_type(4)));
typedef float f32x2 __attribute__((ext_vector_type(2)));
typedef unsigned u32x4 __attribute__((ext_vector_type(4)));
typedef unsigned u32x2 __attribute__((ext_vector_type(2)));

constexpr int T = 32768, D = 2048, SEQ = 16384;
constexpr int EV_IN = 5120, OD_IN = 12288;
constexpr int PMAX = 65536 + 32 * 256, NRT_MAX = PMAX / 256;
constexpr float EPS = 1e-6f;

constexpr size_t MiB = 1u << 20;
constexpr size_t WS_CTL = 0, CTL_ZERO_BYTES = 1 * MiB;
constexpr size_t WS_SMALL = 1 * MiB;
constexpr size_t SM_CNT = WS_SMALL + 0;
constexpr size_t SM_TT = WS_SMALL + 32 * 1024;
constexpr size_t SM_ASGE = WS_SMALL + 64 * 1024;
constexpr size_t SM_ASGR = WS_SMALL + 320 * 1024;
constexpr size_t SM_ASGW = WS_SMALL + 576 * 1024;
constexpr size_t SM_DEST = WS_SMALL + 832 * 1024;
constexpr size_t SM_ROWTOK = WS_SMALL + 1088 * 1024;
constexpr size_t WS_ROT = 4 * MiB;
constexpr size_t WS_WOD = 36 * MiB;
constexpr size_t WS_WODO = 84 * MiB;
constexpr size_t WS_WGU = 100 * MiB;
constexpr size_t WS_WD = 228 * MiB;
constexpr size_t WS_WEVI = 292 * MiB;
constexpr size_t WS_WEVO = 312 * MiB;
constexpr size_t WS_WGATE = 320 * MiB;
constexpr size_t WS_SUB = 321 * MiB;
constexpr size_t WS_CH = 329 * MiB;
constexpr size_t WS_H = 332 * MiB;
constexpr size_t ARENA = 460 * MiB;
constexpr size_t WS_PROJ0 = ARENA;
constexpr size_t WS_XC = 780 * MiB;
constexpr size_t WS_GPRE = 844 * MiB;
constexpr size_t WS_Y0 = 972 * MiB;
constexpr size_t WS_HID = ARENA;
constexpr size_t WS_YBUF = 532 * MiB;
constexpr size_t WS_QCAT = ARENA;
constexpr size_t WS_VRCAT = 588 * MiB;
constexpr size_t WS_KB = 844 * MiB;
constexpr size_t WS_KDT = 908 * MiB;
constexpr size_t WS_YB = 844 * MiB;
constexpr size_t WS_GB = 972 * MiB;
constexpr size_t WS_END = 1100 * MiB;

constexpr int CW_BAR = 4096;

constexpr int LDS_MAIN = 131072;
constexpr int LDS_MISC = LDS_MAIN;
constexpr int LDS_TT = LDS_MAIN + 256;
constexpr int LDS_BYTES = 147456;

__device__ __forceinline__ unsigned f2bf(float f) { unsigned u = __builtin_bit_cast(unsigned, f); return (u + 0x7fffu + ((u >> 16) & 1u)) >> 16; }
__device__ __forceinline__ unsigned pk2(float lo, float hi) { return f2bf(lo) | (f2bf(hi) << 16); }
__device__ __forceinline__ float bf_lo(unsigned w) { return __builtin_bit_cast(float, w << 16); }
__device__ __forceinline__ float bf_hi(unsigned w) { return __builtin_bit_cast(float, w & 0xffff0000u); }
__device__ __forceinline__ float bf2f(bf16_t h) { return __builtin_bit_cast(float, ((unsigned)h) << 16); }
__device__ __forceinline__ float wave_sum(float v) {
#pragma unroll
    for (int o = 1; o < 64; o <<= 1) v += __shfl_xor(v, o);
    return v;
}
__device__ __forceinline__ float sigmoidf_(float x) { return 1.0f / (1.0f + __expf(-x)); }
__device__ __forceinline__ float gelu_tanh(float x) { const float u = 0.7978845608028654f * (x + 0.044715f * x * x * x); const float e = __expf(2.0f * u); const float th = 1.0f - 2.0f / (e + 1.0f); return 0.5f * x * (1.0f + th); }
__device__ __forceinline__ void unpack8(const u32x4 w, float (&f)[8]) { f[0] = bf_lo(w.x); f[1] = bf_hi(w.x); f[2] = bf_lo(w.y); f[3] = bf_hi(w.y); f[4] = bf_lo(w.z); f[5] = bf_hi(w.z); f[6] = bf_lo(w.w); f[7] = bf_hi(w.w); }
__device__ __forceinline__ u32x4 pack8(const float (&f)[8]) { u32x4 w; w.x = pk2(f[0], f[1]); w.y = pk2(f[2], f[3]); w.z = pk2(f[4], f[5]); w.w = pk2(f[6], f[7]); return w; }
#define LDS_WAIT() asm volatile("s_waitcnt lgkmcnt(0)" ::: "memory")

#define XB_TMO      128
#define XB_XCNT(j)  (256  + 64 * (j))
#define XB_XSUB(j)  (1280 + 64 * (j))
#define XB_XGEN(j)  (2304 + 64 * (j))
#define XB_TOP      3328
#define XB_TOPGEN   3392
#define XCD_BAR_WORDS 3456
#define XB_SPIN_CAP (1u << 18)
__device__ __forceinline__ unsigned xb_ld(unsigned* p)              { return __hip_atomic_load(p, __ATOMIC_RELAXED, __HIP_MEMORY_SCOPE_AGENT); }
__device__ __forceinline__ unsigned xb_add(unsigned* p, unsigned v) { return __hip_atomic_fetch_add(p, v, __ATOMIC_RELAXED, __HIP_MEMORY_SCOPE_AGENT); }
__device__ __forceinline__ unsigned xb_xcc_id() { return (unsigned)__builtin_amdgcn_s_getreg((3 << 11) | 20) & 0xFu; }
#define XB_SPIN(cond, bar) do { unsigned _sp = 0; while (cond) { __builtin_amdgcn_s_sleep(1); \
    if ((++_sp & 255u) == 0u) { if (xb_ld(&(bar)[XB_TMO])) break; if (_sp > XB_SPIN_CAP) { atomicAdd(&(bar)[XB_TMO], 1u); break; } } } } while (0)
struct XcdBarrier { unsigned* bar; unsigned x; volatile LAS unsigned* st; };
__device__ __forceinline__ XcdBarrier xcd_barrier_post(unsigned* bar, volatile LAS unsigned* st) {
    XcdBarrier b; b.bar = bar; b.x = xb_xcc_id(); b.st = st;
    if (threadIdx.x == 0) (void)xb_add(&bar[XB_XCNT(b.x)], 1u);
    return b;
}
__device__ __forceinline__ void xcd_barrier_complete(unsigned* bar, unsigned x, unsigned& nloc, unsigned& nx) {
    const unsigned G = gridDim.x * gridDim.y * gridDim.z;
    unsigned sum, cnt, mine, sp = 0u;
    for (;;) {
        sum = 0u; cnt = 0u; mine = 0u;
#pragma unroll
        for (unsigned j = 0; j < 16; ++j) { const unsigned c = xb_ld(&bar[XB_XCNT(j)]); sum += c; cnt += (c > 0u) ? 1u : 0u; mine = (j == x) ? c : mine; }
        if (sum == G) break;
        __builtin_amdgcn_s_sleep(1);
        if ((++sp & 255u) == 0u) { if (xb_ld(&bar[XB_TMO])) break; if (sp > XB_SPIN_CAP) { atomicAdd(&bar[XB_TMO], 1u); break; } }
    }
    nloc = mine > 0u ? mine : 1u; nx = cnt > 0u ? cnt : 1u;
}
__device__ __forceinline__ void xcd_barrier(const XcdBarrier& b) {
    asm volatile("s_waitcnt vmcnt(0)" ::: "memory");
    __syncthreads();
    if (threadIdx.x == 0) {
        unsigned* bar = b.bar;
        __builtin_amdgcn_s_waitcnt(0);
        unsigned nloc = b.st[0], nx = b.st[1];
        if (nloc == 0u) { xcd_barrier_complete(bar, b.x, nloc, nx); b.st[0] = nloc; b.st[1] = nx; }
        const unsigned old = xb_add(&bar[XB_XSUB(b.x)], 1u);
        const unsigned gen = old / nloc;
        if (old + 1u == (gen + 1u) * nloc) {
            __builtin_amdgcn_fence(__ATOMIC_RELEASE, "agent");
            asm volatile("s_waitcnt vmcnt(0)" ::: "memory");
            const unsigned og = xb_add(&bar[XB_TOP], 1u);
            const unsigned tg = og / nx;
            if (og + 1u == (tg + 1u) * nx) xb_add(&bar[XB_TOPGEN], 1u);
            else XB_SPIN(xb_ld(&bar[XB_TOPGEN]) == tg, bar);
            __builtin_amdgcn_fence(__ATOMIC_ACQUIRE, "agent");
            xb_add(&bar[XB_XGEN(b.x)], 1u);
            asm volatile("s_waitcnt vmcnt(0)" ::: "memory");
        } else {
            XB_SPIN(xb_ld(&bar[XB_XGEN(b.x)]) == gen, bar);
            __builtin_amdgcn_fence(__ATOMIC_ACQUIRE, "agent");
            asm volatile("s_waitcnt vmcnt(0)" ::: "memory");
        }
    }
    __syncthreads();
}

namespace pg8 {
constexpr int BM = 256, BK = 64, HALF = 128, HTB = HALF * BK * 2, STAGE_BYTES = 8 * HTB, NXCD = 8, WGM = 8;
__device__ __forceinline__ int lds_byte(int r, int c) { const int st = (r >> 4) * 2 + (c >> 5), rr = r & 15, cc = c & 31, ob = rr * 64 + cc * 2; return st * 1024 + (ob ^ (((ob >> 9) & 1) << 5)); }
__device__ __forceinline__ void stage_rc(int b, int& R, int& C) { const int st = b / 1024, sb = b % 1024, swz = sb ^ (((sb >> 9) & 1) << 5); R = (st >> 1) * 16 + swz / 64; C = (st & 1) * 32 + (swz % 64) / 2; }
__device__ __forceinline__ int perm32(int rho) { const int n = rho >> 4, i = rho & 15; return 8 * (i >> 2) + 4 * n + (i & 3); }

struct Unit { const char* a; const char* b; int pm, pn, x0, x1; };

__device__ __forceinline__ void tile_order(int L, int nM, int nN, int& pm, int& pn) {
    const int nwg = nM * nN; int wgid = L;
    { const int q = nwg / NXCD, r = nwg % NXCD, xcd = wgid % NXCD, off = wgid / NXCD; wgid = (xcd < r ? xcd * (q + 1) : r * (q + 1) + (xcd - r) * q) + off; }
    const int nig = WGM * nN, gid = wgid / nig, fm = gid * WGM, gsz = (nM - fm) < WGM ? (nM - fm) : WGM;
    pm = fm + ((wgid % nig) % gsz); pn = (wgid % nig) / gsz;
}

template <class Epi, class Sched>
__device__ __forceinline__ void gemm_phase(LAS unsigned char* lds, const Sched& S, const Epi& E) {
    int tid_ = threadIdx.x; asm volatile("" : "+v"(tid_));
    const int tid = tid_, wid = __builtin_amdgcn_readfirstlane(tid >> 6), lane = tid & 63, wr = wid >> 2, wc = wid & 3, fr = lane & 15, fq = lane >> 4;
    const int nt = S.K / BK;
    int sR[2], sC[2];
    unsigned voffB[2];
#pragma unroll
    for (int i = 0; i < 2; ++i) { stage_rc(tid * 16 + i * 8192, sR[i], sC[i]); const int Rb = Epi::PERM ? ((sR[i] & ~31) + perm32(sR[i] & 31)) : sR[i];
        voffB[i] = (unsigned)(Rb * S.ldb + sC[i]) * 2u; }
    const size_t kstep = (size_t)(BK * 2);
    const size_t hstepB = (size_t)HALF * S.ldb * 2, hstepA = (size_t)HALF * S.lda * 2;
    const unsigned ldsw = (unsigned)wid * 1024u;
    const int aoff = lds_byte(wr * 64 + fr, fq * 8), boff = lds_byte(wc * 32 + fr, fq * 8);
#define PG8_SA(b, h) (((b) * 2 + (h)) * HTB)
#define PG8_SB(b, h) ((4 + (b) * 2 + (h)) * HTB)
#define PG8_STAGE2(bufoff, gbase, v0, v1) do { \
        __builtin_amdgcn_global_load_lds((const unsigned*)((const char*)(gbase) + (v0)), (LAS unsigned*)(lds + (bufoff) + ldsw), 16, 0, 0); \
        __builtin_amdgcn_global_load_lds((const unsigned*)((const char*)(gbase) + (v1)), (LAS unsigned*)(lds + (bufoff) + ldsw + 8192), 16, 0, 0); } while (0)
#define PG8_STAGEB(b, h, gbase) PG8_STAGE2(PG8_SB(b, h), (gbase) + (h) * hstepB, voffB[0], voffB[1])
#define PG8_STAGEA(b, h, gbase, V) do { if constexpr (Sched::GATHER) { PG8_STAGE2(PG8_SA(b, h), gbase, V[h][0], V[h][1]); } else { PG8_STAGE2(PG8_SA(b, h), (gbase) + (h) * hstepA, V[0][0], V[0][1]); } } while (0)
#define PG8_LDA(dst, b, h) do { _Pragma("unroll") for (int m = 0; m < 4; ++m) _Pragma("unroll") for (int k = 0; k < 2; ++k) dst[m][k] = *(const LAS bf16x8*)(lds + PG8_SA(b, h) + aoff + m * 2048 + k * 1024); } while (0)
#define PG8_LDB(dst, b, h) do { _Pragma("unroll") for (int n = 0; n < 2; ++n) _Pragma("unroll") for (int k = 0; k < 2; ++k) dst[n][k] = *(const LAS bf16x8*)(lds + PG8_SB(b, h) + boff + n * 2048 + k * 1024); } while (0)
#define PG8_MMA(ai, bj, At, Bt) do { __builtin_amdgcn_s_setprio(1); _Pragma("unroll") for (int m = 0; m < 4; ++m) _Pragma("unroll") for (int n = 0; n < 2; ++n) _Pragma("unroll") for (int k = 0; k < 2; ++k) \
        acc[ai][bj][m][n] = __builtin_amdgcn_mfma_f32_16x16x32_bf16(Bt[n][k], At[m][k], acc[ai][bj][m][n], 0, 0, 0); __builtin_amdgcn_s_setprio(0); } while (0)
#define PG8_WAIT_V(n) asm volatile("s_waitcnt vmcnt(" #n ")" ::: "memory")
#define PG8_WAIT_L(n) asm volatile("s_waitcnt lgkmcnt(" #n ")" ::: "memory")
#define PG8_BAR __builtin_amdgcn_s_barrier()
#define PG8_SCHED __builtin_amdgcn_sched_barrier(0)
#define PG8_CALC_VA(u, V) do { _Pragma("unroll") for (int _h = 0; _h < 2; ++_h) _Pragma("unroll") for (int _i = 0; _i < 2; ++_i) { \
        if constexpr (Sched::GATHER) V[_h][_i] = S.row_off(u, sR[_i] + HALF * _h) + (unsigned)sC[_i] * 2u; \
        else V[_h][_i] = (unsigned)((sR[_i] + HALF * _h) * S.lda + sC[_i]) * 2u; } } while (0)
    Unit cur, nxt; int ui = 0;
    if (!S.next(0, cur)) return;
    f32x4 acc[2][2][4][2];
#pragma unroll
    for (int a = 0; a < 2; ++a)
#pragma unroll
        for (int b = 0; b < 2; ++b)
#pragma unroll
            for (int m = 0; m < 4; ++m)
#pragma unroll
                for (int n = 0; n < 2; ++n) acc[a][b][m][n] = (f32x4){0.f, 0.f, 0.f, 0.f};
    bf16x8 At[4][2], B0[2][2], B1[2][2];
    unsigned vA[2][2], vN[2][2];
    PG8_CALC_VA(cur, vA);
    const char* cA = cur.a; const char* cB = cur.b;
    PG8_STAGEB(0, 0, cB); PG8_STAGEB(0, 1, cB); PG8_STAGEA(0, 0, cA, vA); PG8_STAGEA(0, 1, cA, vA);
    if (wr == 1) PG8_BAR;
    PG8_WAIT_V(2); PG8_BAR;
    PG8_STAGEB(1, 0, cB + kstep); PG8_STAGEA(1, 0, cA + kstep, vA); PG8_STAGEB(1, 1, cB + kstep);
    PG8_WAIT_V(6); PG8_BAR;
    for (;;) {
        const bool has_next = S.next(ui + 1, nxt);
        const char* nA = has_next ? nxt.a : cA; const char* nB = has_next ? nxt.b : cB;
        if constexpr (Sched::GATHER) { if (has_next) { PG8_CALC_VA(nxt, vN); } else {
#pragma unroll
            for (int _h = 0; _h < 2; ++_h)
#pragma unroll
                for (int _i = 0; _i < 2; ++_i) vN[_h][_i] = vA[_h][_i]; } }
#pragma unroll 1
        for (int t = 0; t < nt; t += 2) {
            const bool last = (t == nt - 2);
            const char* a1 = cA + (size_t)(t + 1) * kstep;
            const char* a2 = last ? nA : cA + (size_t)(t + 2) * kstep; const char* b2 = last ? nB : cB + (size_t)(t + 2) * kstep;
            const char* a3 = a2 + kstep; const char* b3 = b2 + kstep;
            unsigned vS[2][2];
#pragma unroll
            for (int _h = 0; _h < 2; ++_h)
#pragma unroll
                for (int _i = 0; _i < 2; ++_i) { if constexpr (Sched::GATHER) vS[_h][_i] = last ? vN[_h][_i] : vA[_h][_i]; else vS[_h][_i] = vA[_h][_i]; }
            PG8_LDB(B0, 0, 0); PG8_LDB(B1, 0, 1); PG8_SCHED; PG8_LDA(At, 0, 0); PG8_STAGEA(1, 1, a1, vA);
            PG8_WAIT_V(8); PG8_WAIT_L(0); PG8_BAR; PG8_MMA(0, 0, At, B0); PG8_MMA(0, 1, At, B1); PG8_BAR; PG8_SCHED;
            PG8_LDA(At, 0, 1); PG8_STAGEB(0, 0, b2); PG8_STAGEB(0, 1, b2); PG8_STAGEA(0, 0, a2, vS);
            PG8_WAIT_V(8); PG8_WAIT_L(0); PG8_BAR; PG8_MMA(1, 0, At, B0); PG8_MMA(1, 1, At, B1); PG8_BAR; PG8_SCHED;
            PG8_LDB(B0, 1, 0); PG8_LDB(B1, 1, 1); PG8_SCHED; PG8_LDA(At, 1, 0); PG8_STAGEA(0, 1, a2, vS);
            PG8_WAIT_V(8); PG8_WAIT_L(0); PG8_BAR; PG8_MMA(0, 0, At, B0); PG8_MMA(0, 1, At, B1); PG8_BAR; PG8_SCHED;
            PG8_LDA(At, 1, 1); PG8_STAGEB(1, 0, b3); PG8_STAGEB(1, 1, b3); PG8_STAGEA(1, 0, a3, vS);
            PG8_WAIT_V(8); PG8_WAIT_L(0); PG8_BAR; PG8_MMA(1, 0, At, B0); PG8_MMA(1, 1, At, B1); PG8_BAR; PG8_SCHED;
        }
        if (wr == 0) PG8_BAR;
        E(acc, cur, wr, wc, fr, fq);
        if (!has_next) break;
#pragma unroll
        for (int a = 0; a < 2; ++a)
#pragma unroll
            for (int b = 0; b < 2; ++b)
#pragma unroll
                for (int m = 0; m < 4; ++m)
#pragma unroll
                    for (int n = 0; n < 2; ++n) acc[a][b][m][n] = (f32x4){0.f, 0.f, 0.f, 0.f};
        cur = nxt; cA = nA; cB = nB; ++ui;
        if constexpr (Sched::GATHER) {
#pragma unroll
            for (int _h = 0; _h < 2; ++_h)
#pragma unroll
                for (int _i = 0; _i < 2; ++_i) vA[_h][_i] = vN[_h][_i]; }
        if (wr == 1) PG8_BAR;
    }
    PG8_WAIT_V(0);
    PG8_BAR;
#undef PG8_SA
#undef PG8_SB
#undef PG8_STAGE2
#undef PG8_STAGEA
#undef PG8_STAGEB
#undef PG8_LDA
#undef PG8_LDB
#undef PG8_MMA
#undef PG8_WAIT_V
#undef PG8_WAIT_L
#undef PG8_BAR
#undef PG8_SCHED
#undef PG8_CALC_VA
}

template <int nM, int nN, int LDA, int LDB, int KK>
struct DenseSched {
    static constexpr bool GATHER = false;
    static constexpr int K = KK, lda = LDA, ldb = LDB;
    const char* A; const char* B; int G, c;
    __device__ __forceinline__ bool next(int i, Unit& u) const {
        const int L = i * G + c; if (L >= nM * nN) return false;
        int pm, pn; tile_order(L, nM, nN, pm, pn);
        u.pm = pm; u.pn = pn; u.x0 = 0; u.x1 = 0; u.a = A + (size_t)pm * BM * lda * 2; u.b = B + (size_t)pn * BM * ldb * 2; return true;
    }
    __device__ __forceinline__ unsigned row_off(const Unit&, int) const { return 0u; }
};
}

typedef const f32x4 (&AccRef)[2][2][4][2];

struct EpiPlain {
    static constexpr bool PERM = true;
    bf16_t* out; int ldc; size_t pm_stride, pn_stride;
    __device__ __forceinline__ void operator()(AccRef acc, const pg8::Unit& u, int wr, int wc, int fr, int fq) const {
        bf16_t* tile = out + (size_t)u.pm * pm_stride + (size_t)u.pn * pn_stride;
        const int r0 = wr * 64 + fr, c0 = wc * 32 + 8 * fq;
#pragma unroll
        for (int ai = 0; ai < 2; ++ai)
#pragma unroll
            for (int m = 0; m < 4; ++m) { bf16_t* rowp = tile + (size_t)(r0 + ai * 128 + m * 16) * ldc + c0;
#pragma unroll
                for (int bj = 0; bj < 2; ++bj) { const f32x4 v0 = acc[ai][bj][m][0], v1 = acc[ai][bj][m][1];
                    u32x4 w; w.x = pk2(v0[0], v0[1]); w.y = pk2(v0[2], v0[3]); w.z = pk2(v1[0], v1[1]); w.w = pk2(v1[2], v1[3]);
                    *(u32x4*)(rowp + bj * 128) = w; } }
    }
};
struct EpiUnitPtr {
    static constexpr bool PERM = true;
    bf16_t* out; int ldc;
    __device__ __forceinline__ void operator()(AccRef acc, const pg8::Unit& u, int wr, int wc, int fr, int fq) const {
        bf16_t* tile = out + (((size_t)(unsigned)u.x1 << 32) | (size_t)(unsigned)u.x0);
        const int r0 = wr * 64 + fr, c0 = wc * 32 + 8 * fq;
#pragma unroll
        for (int ai = 0; ai < 2; ++ai)
#pragma unroll
            for (int m = 0; m < 4; ++m) { bf16_t* rowp = tile + (size_t)(r0 + ai * 128 + m * 16) * ldc + c0;
#pragma unroll
                for (int bj = 0; bj < 2; ++bj) { const f32x4 v0 = acc[ai][bj][m][0], v1 = acc[ai][bj][m][1];
                    u32x4 w; w.x = pk2(v0[0], v0[1]); w.y = pk2(v0[2], v0[3]); w.z = pk2(v1[0], v1[1]); w.w = pk2(v1[2], v1[3]);
                    *(u32x4*)(rowp + bj * 128) = w; } }
    }
};
struct EpiResid {
    static constexpr bool PERM = false;
    const float* base; float* out; int row0;
    __device__ __forceinline__ void operator()(AccRef acc, const pg8::Unit& u, int wr, int wc, int fr, int fq) const {
        const int r0 = row0 + u.pm * 256 + wr * 64 + fr, c0 = u.pn * 256 + wc * 32 + 4 * fq;
#pragma unroll
        for (int ai = 0; ai < 2; ++ai)
#pragma unroll
            for (int m = 0; m < 4; ++m) { const size_t off = (size_t)(r0 + ai * 128 + m * 16) * D + c0;
#pragma unroll
                for (int bj = 0; bj < 2; ++bj)
#pragma unroll
                    for (int n = 0; n < 2; ++n) { const f32x4 bs = *(const f32x4*)(base + off + bj * 128 + n * 16); *(f32x4*)(out + off + bj * 128 + n * 16) = bs + acc[ai][bj][m][n]; }
                asm volatile("" ::: "memory"); }
    }
};
struct EpiSwiGLU {
    static constexpr bool PERM = true;
    bf16_t* hid;
    __device__ __forceinline__ void operator()(AccRef acc, const pg8::Unit& u, int wr, int wc, int fr, int fq) const {
        bf16_t* tile = hid + (size_t)u.pm * 256 * 512 + u.pn * 128;
        const int r0 = wr * 64 + fr, c0 = wc * 32 + 8 * fq;
#pragma unroll
        for (int ai = 0; ai < 2; ++ai)
#pragma unroll
            for (int m = 0; m < 4; ++m) { bf16_t* rowp = tile + (size_t)(r0 + ai * 128 + m * 16) * 512 + c0;
                float o[8];
#pragma unroll
                for (int n = 0; n < 2; ++n)
#pragma unroll
                    for (int j = 0; j < 4; ++j) { const float g = acc[ai][0][m][n][j], up = acc[ai][1][m][n][j]; o[n * 4 + j] = g * sigmoidf_(g) * up; }
                *(u32x4*)rowp = pack8(o); }
    }
};
struct EpiSilu {
    static constexpr bool PERM = true;
    bf16_t* out; int ldc;
    __device__ __forceinline__ void operator()(AccRef acc, const pg8::Unit& u, int wr, int wc, int fr, int fq) const {
        bf16_t* tile = out + (size_t)u.pm * 256 * ldc + u.pn * 256;
        const int r0 = wr * 64 + fr, c0 = wc * 32 + 8 * fq;
#pragma unroll
        for (int ai = 0; ai < 2; ++ai)
#pragma unroll
            for (int m = 0; m < 4; ++m) { bf16_t* rowp = tile + (size_t)(r0 + ai * 128 + m * 16) * ldc + c0;
#pragma unroll
                for (int bj = 0; bj < 2; ++bj) { float o[8];
#pragma unroll
                    for (int n = 0; n < 2; ++n)
#pragma unroll
                        for (int j = 0; j < 4; ++j) { const float g = acc[ai][bj][m][n][j]; o[n * 4 + j] = g * sigmoidf_(g); }
                    *(u32x4*)(rowp + bj * 128) = pack8(o); } }
    }
};
struct EpiRotary {
    static constexpr bool PERM = true;
    bf16_t* out; int ldc; size_t pm_stride, pn_stride; const float* rot; int tok0; float scale;
    __device__ __forceinline__ void operator()(AccRef acc, const pg8::Unit& u, int wr, int wc, int fr, int fq) const {
        bf16_t* tile = out + (size_t)u.pm * pm_stride + (size_t)u.pn * pn_stride;
        const int r0 = wr * 64 + fr, c0 = wc * 32 + 8 * fq;
#pragma unroll
        for (int ai = 0; ai < 2; ++ai)
#pragma unroll
            for (int m = 0; m < 4; ++m) { const int r = r0 + ai * 128 + m * 16; bf16_t* rowp = tile + (size_t)r * ldc + c0;
                const float* rt = rot + ((size_t)(tok0 + u.pm * 256 + r) * 128 + (c0 >> 1)) * 2;
#pragma unroll
                for (int bj = 0; bj < 2; ++bj) { const f32x4 cs0 = *(const f32x4*)(rt + bj * 128), cs1 = *(const f32x4*)(rt + bj * 128 + 4);
                    const f32x4 v0 = acc[ai][bj][m][0], v1 = acc[ai][bj][m][1]; float o[8];
                    o[0] = (v0[0] * cs0[0] - v0[1] * cs0[1]) * scale; o[1] = (v0[1] * cs0[0] + v0[0] * cs0[1]) * scale;
                    o[2] = (v0[2] * cs0[2] - v0[3] * cs0[3]) * scale; o[3] = (v0[3] * cs0[2] + v0[2] * cs0[3]) * scale;
                    o[4] = (v1[0] * cs1[0] - v1[1] * cs1[1]) * scale; o[5] = (v1[1] * cs1[0] + v1[0] * cs1[1]) * scale;
                    o[6] = (v1[2] * cs1[2] - v1[3] * cs1[3]) * scale; o[7] = (v1[3] * cs1[2] + v1[2] * cs1[3]) * scale;
                    *(u32x4*)(rowp + bj * 128) = pack8(o); } }
    }
};
struct EpiSprime {
    static constexpr bool PERM = true;
    bf16_t* qcat;
    __device__ __forceinline__ void operator()(AccRef acc, const pg8::Unit& u, int wr, int wc, int fr, int fq) const {
        bf16_t* tile = qcat + ((size_t)u.x0 * 16384 + (size_t)u.pm * 256) * 512;
        const float l2g = __log2f(1.0f - exp2f(-5.0f - (float)u.x0));
        const int r0 = wr * 64 + fr, c0 = wc * 32 + 8 * fq;
#pragma unroll
        for (int bj = 0; bj < 2; ++bj) {
            float cf[8];
#pragma unroll
            for (int j = 0; j < 8; ++j) cf[j] = __builtin_amdgcn_exp2f(-(float)(c0 + bj * 128 + j + 1) * l2g);
#pragma unroll
            for (int ai = 0; ai < 2; ++ai)
#pragma unroll
                for (int m = 0; m < 4; ++m) { const int r = r0 + ai * 128 + m * 16; bf16_t* rowp = tile + (size_t)r * 512 + c0; float o[8];
#pragma unroll
                    for (int n = 0; n < 2; ++n)
#pragma unroll
                        for (int j = 0; j < 4; ++j) { const int c = c0 + bj * 128 + n * 4 + j; o[n * 4 + j] = (c <= r) ? acc[ai][bj][m][n][j] * cf[n * 4 + j] : 0.f; }
                    *(u32x4*)(rowp + bj * 128) = pack8(o); }
        }
    }
};
struct EpiY {
    static constexpr bool PERM = true;
    bf16_t* yb;
    __device__ __forceinline__ void operator()(AccRef acc, const pg8::Unit& u, int wr, int wc, int fr, int fq) const {
        bf16_t* tile = yb + (size_t)u.pm * 256 * 4096 + u.x0 * 512 + u.pn * 256;
        const float l2g = __log2f(1.0f - exp2f(-5.0f - (float)u.x0));
        const int r0 = wr * 64 + fr, c0 = wc * 32 + 8 * fq;
#pragma unroll
        for (int ai = 0; ai < 2; ++ai)
#pragma unroll
            for (int m = 0; m < 4; ++m) { const int r = r0 + ai * 128 + m * 16; bf16_t* rowp = tile + (size_t)r * 4096 + c0; const float rf = __builtin_amdgcn_exp2f((float)(r + 1) * l2g);
#pragma unroll
                for (int bj = 0; bj < 2; ++bj) { const f32x4 v0 = acc[ai][bj][m][0] * rf, v1 = acc[ai][bj][m][1] * rf;
                    u32x4 w; w.x = pk2(v0[0], v0[1]); w.y = pk2(v0[2], v0[3]); w.z = pk2(v1[0], v1[1]); w.w = pk2(v1[2], v1[3]);
                    *(u32x4*)(rowp + bj * 128) = w; } }
    }
};

struct GateSched {
    static constexpr bool GATHER = false;
    const char* A; const char* B; int G, c; static constexpr int lda = 1024, ldb = 256, K = 256;
    __device__ __forceinline__ bool next(int i, pg8::Unit& u) const {
        const int L = i * G + c; if (L >= 128 * 8) return false;
        const int pm = L >> 3, j = (L >> 1) & 3, pn = L & 1;
        u.pm = pm; u.pn = j * 2 + pn; u.x0 = 0; u.x1 = 0; u.a = A + ((size_t)pm * 256 * 1024 + j * 256) * 2; u.b = B + ((size_t)(j * 512 + pn * 256) * 256) * 2; return true;
    }
    __device__ __forceinline__ unsigned row_off(const pg8::Unit&, int) const { return 0u; }
};
struct Moe1Sched {
    static constexpr bool GATHER = true;
    const char* A; const char* B; const int* rowtok; const LAS int* tt; int G, c; static constexpr int lda = 2048, ldb = 2048, K = 2048;
    __device__ __forceinline__ bool next(int i, pg8::Unit& u) const {
        const int L = i * G + c; if (L >= tt[0] * 4) return false;
        const int rt = L >> 2, pn = L & 3, e = tt[1 + rt];
        u.pm = rt; u.pn = pn; u.x0 = e; u.x1 = 0; u.a = A; u.b = B + ((size_t)(e * 1024 + pn * 256) * 2048) * 2; return true;
    }
    __device__ __forceinline__ unsigned row_off(const pg8::Unit& u, int r) const { return (unsigned)rowtok[u.pm * 256 + r] * (unsigned)(2048 * 2); }
};
struct Moe2Sched {
    static constexpr bool GATHER = false;
    const char* A; const char* B; const LAS int* tt; int G, c; static constexpr int lda = 512, ldb = 512, K = 512;
    __device__ __forceinline__ bool next(int i, pg8::Unit& u) const {
        const int L = i * G + c; if (L >= tt[0] * 8) return false;
        const int rt = L >> 3, pn = L & 7, e = tt[1 + rt];
        u.pm = rt; u.pn = pn; u.x0 = e; u.x1 = 0; u.a = A + (size_t)rt * 256 * 512 * 2; u.b = B + ((size_t)(e * 2048 + pn * 256) * 512) * 2; return true;
    }
    __device__ __forceinline__ unsigned row_off(const pg8::Unit&, int) const { return 0u; }
};
struct SpSched {
    static constexpr bool GATHER = false;
    const char* qcat; const char* kb; int G, c; static constexpr int lda = 512, ldb = 2048, K = 256;
    __device__ __forceinline__ bool next(int i, pg8::Unit& u) const {
        const int L = i * G + c; if (L >= 512) return false;
        const int h = L >> 6, n = L & 63;
        u.pm = n; u.pn = 0; u.x0 = h; u.x1 = 0; u.a = qcat + (((size_t)h * 16384 + (size_t)n * 256) * 512 + 256) * 2; u.b = kb + ((size_t)n * 256 * 2048 + h * 256) * 2; return true;
    }
    __device__ __forceinline__ unsigned row_off(const pg8::Unit&, int) const { return 0u; }
};
struct KvSched {
    static constexpr bool GATHER = false;
    const char* vr; const char* kdt; int G, c; static constexpr int lda = 512, ldb = 16384, K = 256;
    __device__ __forceinline__ bool next(int i, pg8::Unit& u) const {
        const int L = i * G + c; if (L >= 1024) return false;
        const int hn = L >> 1, pe = L & 1, h = hn >> 6, n = hn & 63;
        const size_t o = ((size_t)hn * 512 + pe * 256) * 512;
        u.pm = 0; u.pn = 0; u.x0 = (int)(unsigned)((o + 256) & 0xffffffffu); u.x1 = (int)(unsigned)((o + 256) >> 32);
        u.a = vr + o * 2; u.b = kdt + ((size_t)h * 256 * 16384 + (size_t)n * 256) * 2; return true;
    }
    __device__ __forceinline__ unsigned row_off(const pg8::Unit&, int) const { return 0u; }
};
struct YSched {
    static constexpr bool GATHER = false;
    const char* qcat; const char* vr; int G, c; static constexpr int lda = 512, ldb = 512, K = 512;
    __device__ __forceinline__ bool next(int i, pg8::Unit& u) const {
        const int L = i * G + c; if (L >= 1024) return false;
        const int hn = L >> 1, pn = L & 1, h = hn >> 6, n = hn & 63;
        u.pm = n; u.pn = pn; u.x0 = h; u.x1 = 0; u.a = qcat + (((size_t)h * 16384 + (size_t)n * 256) * 512) * 2; u.b = vr + (((size_t)hn * 512 + pn * 256) * 512) * 2; return true;
    }
    __device__ __forceinline__ unsigned row_off(const pg8::Unit&, int) const { return 0u; }
};
struct VtSched {
    static constexpr bool GATHER = false;
    const char* w; const char* hb; int G, c; static constexpr int lda = 2048, ldb = 2048, K = 2048;
    __device__ __forceinline__ bool next(int i, pg8::Unit& u) const {
        const int L = i * G + c; if (L >= 1024) return false;
        int pmE, n; pg8::tile_order(L, 16, 64, pmE, n);
        const int h = pmE >> 1;
        const size_t o = (((size_t)(h * 64 + n)) * 512 + (pmE & 1) * 256) * 512;
        u.pm = pmE; u.pn = n; u.x0 = (int)(unsigned)(o & 0xffffffffu); u.x1 = (int)(unsigned)(o >> 32);
        u.a = w + (size_t)pmE * 256 * 2048 * 2; u.b = hb + (size_t)n * 256 * 2048 * 2; return true;
    }
    __device__ __forceinline__ unsigned row_off(const pg8::Unit&, int) const { return 0u; }
};

struct Args { const void* in[25]; float* out; unsigned char* ws; int ph_lo, ph_hi; int li, pad; };

struct Frame {
    LAS unsigned char* lds; int tid, lane, wave, G, bid;
};

struct RmIdent { __device__ __forceinline__ int operator()(int n) const { return n; } };
struct RmOdIn { __device__ __forceinline__ int operator()(int n) const { if (n >= 4096) return n; const int r = n & 255; return (n & ~255) + (r < 128 ? 2 * r : 2 * (r - 128) + 1); } };
struct RmGU { int add; __device__ __forceinline__ int operator()(int n) const { return (n >> 7) * 256 + (n & 127) + add; } };
template <class RM>
__device__ __forceinline__ void transpose_item(const float* W, int K, int N, bf16_t* WT, const RM rm, LAS float* scr, int item, int lane) {
    const int nblk = N / 32, kb = item / nblk, nb = item % nblk, k0 = 64 * kb, n0 = 32 * nb;
#pragma unroll 8
    for (int i = 0; i < 32; ++i) { const int kk = 2 * i + (lane >> 5); scr[kk * 33 + (lane & 31)] = W[(size_t)(k0 + kk) * N + n0 + (lane & 31)]; }
    LDS_WAIT(); asm volatile("" ::: "memory");
    const int c = lane & 7;
#pragma unroll
    for (int j = 0; j < 4; ++j) { const int n = (lane >> 3) + 8 * j; const LAS float* s = scr + (8 * c) * 33 + n;
        u32x4 o; o.x = pk2(s[0 * 33], s[1 * 33]); o.y = pk2(s[2 * 33], s[3 * 33]); o.z = pk2(s[4 * 33], s[5 * 33]); o.w = pk2(s[6 * 33], s[7 * 33]);
        *(u32x4*)(WT + (size_t)rm(n0 + n) * K + k0 + 8 * c) = o; }
    LDS_WAIT(); asm volatile("" ::: "memory");
}
__device__ __forceinline__ void convert_experts(const Frame& F, const float* wg, const float* wu, const float* wd, unsigned char* ws) {
    LAS float* scr = (LAS float*)(F.lds + F.wave * 16384);
    const int gw = F.bid * 8 + F.wave, NGW = F.G * 8;
    bf16_t* gu = (bf16_t*)(ws + WS_WGU); bf16_t* dd = (bf16_t*)(ws + WS_WD);
    for (int it = gw; it < 3 * 16384; it += NGW) {
        const int which = it >> 14, r = it & 16383, e = r >> 9, ii = r & 511;
        if (which == 0) transpose_item(wg + (size_t)e * 2048 * 512, 2048, 512, gu + (size_t)e * 1024 * 2048, RmGU{0}, scr, ii, F.lane);
        else if (which == 1) transpose_item(wu + (size_t)e * 2048 * 512, 2048, 512, gu + (size_t)e * 1024 * 2048, RmGU{128}, scr, ii, F.lane);
        else transpose_item(wd + (size_t)e * 512 * 2048, 512, 2048, dd + (size_t)e * 2048 * 512, RmIdent{}, scr, ii, F.lane);
    }
}
__device__ __forceinline__ void rms_row_to_bf16(const float* xrow, const float* gain, bf16_t* orow, int lane) {
    const f32x4* xr = (const f32x4*)xrow + lane; const f32x4* gr = (const f32x4*)gain + lane;
    f32x4 v[8]; float s = 0.f;
#pragma unroll
    for (int j = 0; j < 8; ++j) { v[j] = xr[64 * j]; s += (v[j].x * v[j].x + v[j].y * v[j].y) + (v[j].z * v[j].z + v[j].w * v[j].w); }
    const float rstd = 1.0f / sqrtf(wave_sum(s) * (1.0f / D) + EPS);
    u32x2* o8 = (u32x2*)orow + lane;
#pragma unroll
    for (int j = 0; j < 8; ++j) { const f32x4 g = gr[64 * j]; u32x2 w; w.x = pk2(v[j].x * rstd * g.x, v[j].y * rstd * g.y); w.y = pk2(v[j].z * rstd * g.z, v[j].w * rstd * g.w); o8[64 * j] = w; }
}

typedef const __attribute__((address_space(4))) Args* ArgP;
__device__ __forceinline__ ArgP launder(ArgP p) { asm volatile("" : "+s"(p)); return p; }
#define INP(T_, k) ((const T_*)ap->in[k])
__device__ __forceinline__ Frame relaunder(const Frame& f) { Frame g = f; asm volatile("" : "+v"(g.tid)); g.lane = g.tid & 63; g.wave = __builtin_amdgcn_readfirstlane(g.tid >> 6); return g; }

__device__ __forceinline__ void ph_prologue(ArgP ap, const Frame& F_) {
    ap = launder(ap); unsigned char* ws = ap->ws; const Frame F = relaunder(F_);
    const int gw = F.bid * 8 + F.wave, NGW = F.G * 8, gt = F.bid * 512 + F.tid, NGT = F.G * 512;
    LAS float* scr = (LAS float*)(F.lds + F.wave * 16384);
    constexpr int I_A = 32 * 160, I_B = 32 * 64, I_C = 32 * 384, I_D = 64 * 64;
    for (int it = gw; it < I_A + I_B + I_C + I_D; it += NGW) {
        int r = it;
        if (r < I_A) { transpose_item(INP(float, 3), 2048, EV_IN, (bf16_t*)(ws + WS_WEVI), RmIdent{}, scr, r, F.lane); continue; } r -= I_A;
        if (r < I_B) { transpose_item(INP(float, 11), 2048, 2048, (bf16_t*)(ws + WS_WEVO), RmIdent{}, scr, r, F.lane); continue; } r -= I_B;
        if (r < I_C) { transpose_item(INP(float, 13), 2048, OD_IN, (bf16_t*)(ws + WS_WOD), RmOdIn{}, scr, r, F.lane); continue; } r -= I_C;
        transpose_item(INP(float, 15), 4096, 2048, (bf16_t*)(ws + WS_WODO), RmIdent{}, scr, r, F.lane);
    }
    convert_experts(F, INP(float, 21), INP(float, 22), INP(float, 23), ws);
    { bf16_t* wgp = (bf16_t*)(ws + WS_WGATE); const float* ga = INP(float, 6); const float* gx = INP(float, 8);
      for (int idx = gt; idx < 4 * 512 * 256; idx += NGT) { const int j = idx >> 17, o = (idx >> 8) & 511, kk = idx & 255, pn = o >> 8, bx = (o >> 7) & 1, ch = o & 127, g = 2 * j + pn, gk = 2 * j + (kk >> 7), i = kk & 127;
          const float v = (gk == g) ? (bx ? gx : ga)[(g * 128 + i) * 128 + ch] : 0.f; wgp[idx] = (bf16_t)f2bf(v); } }
    { float* rot = (float*)(ws + WS_ROT); const int* positions = INP(int, 1);
      for (int idx = gt; idx < T * 128; idx += NGT) { const int t = idx >> 7, i = idx & 127;
          const float inv = exp2f(-(float)i * (13.287712379549449f / 128.0f)); const float ang = (float)positions[t] * inv;
          const float k = rintf(ang * 0.15915494309189535f); float r = fmaf(-k, 6.28125f, ang); r = fmaf(-k, 1.9353071795864769e-3f, r);
          f32x2 cs; cs.x = __cosf(r); cs.y = __sinf(r); *(f32x2*)(rot + (size_t)idx * 2) = cs; } }
    { const float* x_in = INP(float, 0); const float* g = INP(float, 2); bf16_t* Hb = (bf16_t*)(ws + WS_H);
      for (int m = gw; m < T; m += NGW) rms_row_to_bf16(x_in + (size_t)m * D, g, Hb + (size_t)m * D, F.lane); }
}
__device__ __forceinline__ void ph_inproj0(ArgP ap, const Frame& F_) {
    ap = launder(ap); unsigned char* ws = ap->ws; const Frame F = relaunder(F_);
    pg8::DenseSched<128, 20, 2048, 2048, 2048> S{(const char*)(ws + WS_H), (const char*)(ws + WS_WEVI), F.G, F.bid};
    EpiPlain E{(bf16_t*)(ws + WS_PROJ0), EV_IN, (size_t)256 * EV_IN, 256};
    pg8::gemm_phase(F.lds, S, E);
}
__device__ __forceinline__ void ph_conv_attn(ArgP ap, const Frame& F_) {
    ap = launder(ap); unsigned char* ws = ap->ws; const Frame F = relaunder(F_);
    const int gt = F.bid * 512 + F.tid, NGT = F.G * 512;
    const bf16_t* proj = (const bf16_t*)(ws + WS_PROJ0);
    { bf16_t* xc = (bf16_t*)(ws + WS_XC); const float* cw = INP(float, 4); const float* cb = INP(float, 5);
      for (int it = gt; it < T * 128; it += NGT) { const int t = it >> 7, c8 = (it & 127) * 8, s = t & (SEQ - 1);
          float a[8];
#pragma unroll
          for (int j = 0; j < 8; ++j) a[j] = cb[c8 + j];
#pragma unroll
          for (int k = 0; k < 4; ++k) { if (s - 3 + k >= 0) { const u32x4 w = *(const u32x4*)(proj + (size_t)(t - 3 + k) * EV_IN + c8); float f[8]; unpack8(w, f);
#pragma unroll
                  for (int j = 0; j < 8; ++j) a[j] = fmaf(cw[k * 1024 + c8 + j], f[j], a[j]); } }
          *(u32x4*)(xc + (size_t)t * 1024 + c8) = pack8(a); } }
    LAS unsigned char* L = F.lds;
    LAS bf16_t* Qs = (LAS bf16_t*)(L);
    LAS float* Zs = (LAS float*)(L);
    LAS bf16_t* Ks = (LAS bf16_t*)(L + 34816);
    LAS bf16_t* VTs = (LAS bf16_t*)(L + 52224);
    LAS bf16_t* Ps = (LAS bf16_t*)(L + 70656);
    LAS bf16_t* Os = (LAS bf16_t*)(L);
    volatile LAS unsigned* alive = (volatile LAS unsigned*)(L + 89088);
    bf16_t* y0 = (bf16_t*)(ws + WS_Y0);
    const int w = F.wave, l = F.lane, l15 = l & 15, l4 = l >> 4;
    const float scale = 0.08838834764831845f;
    for (int u = F.bid; u < 2048; u += F.G) {
        const int b = u >> 10, h = (u >> 7) & 7, qt = u & 127; const int t0 = b * SEQ + qt * 128;
        __syncthreads();
        for (int i = 0; i < 4; ++i) { const int id = F.tid + 512 * i, row = id >> 4, ch = id & 15;
            *(LAS u32x4*)(Qs + row * 136 + ch * 8) = *(const u32x4*)(proj + (size_t)(t0 + row) * EV_IN + 2048 + h * 128 + ch * 8); }
        __syncthreads();
        bf16x8 qf[4];
#pragma unroll
        for (int ks = 0; ks < 4; ++ks) qf[ks] = *(const LAS bf16x8*)(Qs + (16 * w + l15) * 136 + 32 * ks + 8 * l4);
        f32x4 o[8];
#pragma unroll
        for (int dt = 0; dt < 8; ++dt) o[dt] = (f32x4){0.f, 0.f, 0.f, 0.f};
        float carry = 0.f;
        const int srow = F.tid >> 2, sp = F.tid & 3;
        for (int kb = 2 * qt + 1; kb >= 0; --kb) {
            const int k0 = b * SEQ + kb * 64;
            __syncthreads();
            for (int i = 0; i < 2; ++i) { const int id = F.tid + 512 * i, row = id >> 4, ch = id & 15;
                *(LAS u32x4*)(Ks + row * 136 + ch * 8) = *(const u32x4*)(proj + (size_t)(k0 + row) * EV_IN + 3072 + h * 128 + ch * 8); }
            for (int i = 0; i < 2; ++i) { const int id = F.tid + 512 * i, key = id & 63, ch = id >> 6;
                const u32x4 vv = *(const u32x4*)(proj + (size_t)(k0 + key) * EV_IN + 4096 + h * 128 + ch * 8);
                const unsigned ww[4] = {vv.x, vv.y, vv.z, vv.w};
#pragma unroll
                for (int j = 0; j < 4; ++j) { VTs[(8 * ch + 2 * j) * 72 + key] = (bf16_t)(ww[j] & 0xffffu); VTs[(8 * ch + 2 * j + 1) * 72 + key] = (bf16_t)(ww[j] >> 16); } }
            if (F.tid == 0) alive[0] = 0u;
            __syncthreads();
            f32x4 sacc[4];
#pragma unroll
            for (int kt = 0; kt < 4; ++kt) { sacc[kt] = (f32x4){0.f, 0.f, 0.f, 0.f};
#pragma unroll
                for (int ks = 0; ks < 4; ++ks) { const bf16x8 kf = *(const LAS bf16x8*)(Ks + (16 * kt + l15) * 136 + 32 * ks + 8 * l4);
                    sacc[kt] = __builtin_amdgcn_mfma_f32_16x16x32_bf16(qf[ks], kf, sacc[kt], 0, 0, 0); } }
#pragma unroll
            for (int kt = 0; kt < 4; ++kt)
#pragma unroll
                for (int rg = 0; rg < 4; ++rg) Zs[(16 * w + 4 * l4 + rg) * 68 + 16 * kt + l15] = sacc[kt][rg] * scale;
            __syncthreads();
            { float z[16], m1[16];
#pragma unroll
              for (int j4 = 0; j4 < 4; ++j4) { const f32x4 zz = *(const LAS f32x4*)(Zs + srow * 68 + 16 * sp + 4 * j4); z[4 * j4] = zz.x; z[4 * j4 + 1] = zz.y; z[4 * j4 + 2] = zz.z; z[4 * j4 + 3] = zz.w; }
              const int qs = qt * 128 + srow;
              float tot = 0.f;
#pragma unroll
              for (int j = 0; j < 16; ++j) { const int ksq = kb * 64 + 16 * sp + j; const bool ok = ksq < qs;
                  const float sp_ = fmaxf(z[j], 0.f) + __logf(1.0f + __expf(-fabsf(z[j])));
                  m1[j] = ok ? -sp_ : 0.f; tot += m1[j]; }
              const float t1 = __shfl_down(tot, 1), t2 = __shfl_down(tot, 2), t3 = __shfl_down(tot, 3);
              const float hi_sum = (sp < 3 ? t1 : 0.f) + (sp < 2 ? t2 : 0.f) + (sp < 1 ? t3 : 0.f);
              float run = carry + hi_sum;
              const float rowtot = __shfl(tot + hi_sum, (l & ~3));
              float pw[16];
#pragma unroll
              for (int j = 15; j >= 0; --j) { const int ksq = kb * 64 + 16 * sp + j; const bool ok = ksq < qs;
                  pw[j] = ok ? __expf(m1[j] + z[j] + run) : 0.f; run += m1[j]; }
              carry += rowtot;
              u32x4 w0, w1; w0.x = pk2(pw[0], pw[1]); w0.y = pk2(pw[2], pw[3]); w0.z = pk2(pw[4], pw[5]); w0.w = pk2(pw[6], pw[7]);
              w1.x = pk2(pw[8], pw[9]); w1.y = pk2(pw[10], pw[11]); w1.z = pk2(pw[12], pw[13]); w1.w = pk2(pw[14], pw[15]);
              *(LAS u32x4*)(Ps + srow * 72 + 16 * sp) = w0; *(LAS u32x4*)(Ps + srow * 72 + 16 * sp + 8) = w1;
              if (carry > -104.0f) alive[0] = 1u; }
            __syncthreads();
#pragma unroll
            for (int ks = 0; ks < 2; ++ks) { const bf16x8 pf = *(const LAS bf16x8*)(Ps + (16 * w + l15) * 72 + 32 * ks + 8 * l4);
#pragma unroll
                for (int dt = 0; dt < 8; ++dt) { const bf16x8 vf = *(const LAS bf16x8*)(VTs + (16 * dt + l15) * 72 + 32 * ks + 8 * l4);
                    o[dt] = __builtin_amdgcn_mfma_f32_16x16x32_bf16(pf, vf, o[dt], 0, 0, 0); } }
            if (alive[0] == 0u) break;
        }
        __syncthreads();
#pragma unroll
        for (int dt = 0; dt < 8; ++dt)
#pragma unroll
            for (int rg = 0; rg < 4; ++rg) Os[(16 * w + 4 * l4 + rg) * 136 + 16 * dt + l15] = (bf16_t)f2bf(o[dt][rg]);
        __syncthreads();
        for (int i = 0; i < 4; ++i) { const int id = F.tid + 512 * i, row = id >> 4, ch = id & 15;
            *(u32x4*)(y0 + (size_t)(t0 + row) * 2048 + 1024 + h * 128 + ch * 8) = *(const LAS u32x4*)(Os + row * 136 + ch * 8); }
    }
    __syncthreads();
}
__device__ __forceinline__ void ph_gates(ArgP ap, const Frame& F_) {
    ap = launder(ap); unsigned char* ws = ap->ws; const Frame F = relaunder(F_);
    GateSched S{(const char*)(ws + WS_XC), (const char*)(ws + WS_WGATE), F.G, F.bid};
    EpiPlain E{(bf16_t*)(ws + WS_GPRE), 2048, (size_t)256 * 2048, 256};
    pg8::gemm_phase(F.lds, S, E);
}
__device__ __forceinline__ void ph_scan(ArgP ap, const Frame& F_, const int pass) {
    ap = launder(ap); unsigned char* ws = ap->ws; const Frame F = relaunder(F_);
    const bf16_t* gpre = (const bf16_t*)(ws + WS_GPRE); const bf16_t* xc = (const bf16_t*)(ws + WS_XC); const bf16_t* proj = (const bf16_t*)(ws + WS_PROJ0);
    f32x2* SUB = (f32x2*)(ws + WS_SUB); f32x2* CH = (f32x2*)(ws + WS_CH); bf16_t* y0 = (bf16_t*)(ws + WS_Y0);
    LAS f32x2* Ls = (LAS f32x2*)F.lds;
    const int cg = F.tid & 127, sub = F.tid >> 7, ch0 = cg * 8, g = ch0 >> 7, chin = ch0 & 127;
    float ba[8], bx[8], spl[8];
    { const float* gab = INP(float, 7); const float* gxb = INP(float, 9); const float* lamp = INP(float, 10);
#pragma unroll
      for (int j = 0; j < 8; ++j) { ba[j] = gab[ch0 + j]; bx[j] = gxb[ch0 + j]; const float lam = lamp[ch0 + j]; spl[j] = fmaxf(-lam, 0.f) + log1pf(__expf(-fabsf(lam))); } }
    for (int u = F.bid; u < 256; u += F.G) {
        const int b = u >> 7, c = u & 127;
        float hst[8], Ast[8];
#pragma unroll
        for (int j = 0; j < 8; ++j) { hst[j] = 0.f; Ast[j] = 1.f; }
        __syncthreads();
        if (pass == 1) {
            { const int c2 = F.tid * 2; float h0 = 0.f, h1 = 0.f;
              for (int cc = 0; cc < c; ++cc) { const f32x4 s = *(const f32x4*)(CH + ((size_t)(b * 128 + cc) * 1024 + c2)); h0 = fmaf(s.x, h0, s.y); h1 = fmaf(s.z, h1, s.w); }
              ((LAS float*)Ls)[c2] = h0; ((LAS float*)Ls)[c2 + 1] = h1; }
            __syncthreads();
#pragma unroll
            for (int j = 0; j < 8; ++j) hst[j] = ((LAS float*)Ls)[ch0 + j];
            for (int s2 = 0; s2 < sub; ++s2) { const f32x2* sp2 = SUB + ((size_t)(b * 512 + c * 4 + s2) * 1024 + ch0);
#pragma unroll
                for (int j = 0; j < 8; ++j) { const f32x2 s = sp2[j]; hst[j] = fmaf(s.x, hst[j], s.y); } }
        }
        const int tbase = b * SEQ + c * 128 + sub * 32;
        for (int i = 0; i < 32; ++i) {
            const size_t t = (size_t)(tbase + i);
            float pa[8], px[8], xv[8];
            unpack8(*(const u32x4*)(gpre + t * 2048 + g * 256 + chin), pa);
            unpack8(*(const u32x4*)(gpre + t * 2048 + g * 256 + 128 + chin), px);
            unpack8(*(const u32x4*)(xc + t * 1024 + ch0), xv);
            float gr[8];
            if (pass == 1) unpack8(*(const u32x4*)(proj + t * EV_IN + 1024 + ch0), gr);
            float outv[8];
#pragma unroll
            for (int j = 0; j < 8; ++j) {
                const float r = sigmoidf_(pa[j] + ba[j]), ig = sigmoidf_(px[j] + bx[j]);
                const float la = -8.0f * r * spl[j]; const float a = __expf(la);
                const float mlt = sqrtf(fmaxf(-expm1f(2.0f * la), 0.f));
                const float uu = mlt * (ig * xv[j]);
                hst[j] = fmaf(a, hst[j], uu); Ast[j] *= a;
                if (pass == 1) outv[j] = hst[j] * gelu_tanh(gr[j]);
            }
            if (pass == 1) *(u32x4*)(y0 + t * 2048 + ch0) = pack8(outv);
        }
        if (pass == 0) {
            f32x2* sp2 = SUB + ((size_t)(b * 512 + c * 4 + sub) * 1024 + ch0);
#pragma unroll
            for (int j = 0; j < 8; ++j) { f32x2 s; s.x = Ast[j]; s.y = hst[j]; sp2[j] = s; Ls[sub * 1024 + ch0 + j] = s; }
            __syncthreads();
            if (sub == 0) {
#pragma unroll
                for (int j = 0; j < 8; ++j) { float A = 1.f, Hh = 0.f;
#pragma unroll
                    for (int s2 = 0; s2 < 4; ++s2) { const f32x2 s = Ls[s2 * 1024 + ch0 + j]; Hh = fmaf(s.x, Hh, s.y); A *= s.x; }
                    f32x2 o; o.x = A; o.y = Hh; CH[(size_t)(b * 128 + c) * 1024 + ch0 + j] = o; }
            }
        }
    }
    __syncthreads();
}
__device__ __forceinline__ void ph_outproj0(ArgP ap, const Frame& F_) {
    ap = launder(ap); unsigned char* ws = ap->ws; const Frame F = relaunder(F_);
    pg8::DenseSched<128, 8, 2048, 2048, 2048> S{(const char*)(ws + WS_Y0), (const char*)(ws + WS_WEVO), F.G, F.bid};
    EpiResid E{INP(float, 0), ap->out, 0};
    pg8::gemm_phase(F.lds, S, E);
}
__device__ __forceinline__ void ph_l1_inproj(ArgP ap, const Frame& F_, const int b) {
    ap = launder(ap); unsigned char* ws = ap->ws; const Frame F = relaunder(F_);
    const char* Hbb = (const char*)(ws + WS_H) + (size_t)b * SEQ * D * 2; const char* wod = (const char*)(ws + WS_WOD); const float* rot = (const float*)(ws + WS_ROT);
    { pg8::DenseSched<64, 8, 2048, 2048, 2048> S{Hbb, wod, F.G, F.bid};
      EpiRotary E{(bf16_t*)(ws + WS_QCAT) + 256, 512, (size_t)256 * 512, (size_t)16384 * 512, rot, b * SEQ, 1.0f};
      pg8::gemm_phase(F.lds, S, E); }
    { pg8::DenseSched<64, 8, 2048, 2048, 2048> S{Hbb, wod + (size_t)2048 * 2048 * 2, F.G, F.bid};
      EpiRotary E{(bf16_t*)(ws + WS_KB), 2048, (size_t)256 * 2048, 256, rot, b * SEQ, 0.0625f};
      pg8::gemm_phase(F.lds, S, E); }
    { pg8::DenseSched<64, 16, 2048, 2048, 2048> S{Hbb, wod + (size_t)8192 * 2048 * 2, F.G, F.bid};
      EpiSilu E{(bf16_t*)(ws + WS_GB), 4096};
      pg8::gemm_phase(F.lds, S, E); }
    { VtSched S{wod + (size_t)4096 * 2048 * 2, Hbb, F.G, F.bid};
      EpiUnitPtr E{(bf16_t*)(ws + WS_VRCAT), 512};
      pg8::gemm_phase(F.lds, S, E); }
}
__device__ __forceinline__ void ph_l1_kt_sp(ArgP ap, const Frame& F_) {
    ap = launder(ap); unsigned char* ws = ap->ws; const Frame F = relaunder(F_);
    bf16_t* qcat = (bf16_t*)(ws + WS_QCAT); bf16_t* kbuf = (bf16_t*)(ws + WS_KB); bf16_t* kdt = (bf16_t*)(ws + WS_KDT);
    { LAS bf16_t* tl = (LAS bf16_t*)F.lds;
      for (int u = F.bid; u < 8 * 256 * 4; u += F.G) {
          const int h = u >> 10, tt = (u >> 2) & 255, dq = u & 3; const int tk0 = tt * 64, d0 = dq * 64;
          const float l2g = __log2f(1.0f - exp2f(-5.0f - (float)h));
          __syncthreads();
          { const int r = F.tid >> 3, c8 = F.tid & 7;
            *(LAS u32x4*)(tl + r * 72 + c8 * 8) = *(const u32x4*)(kbuf + (size_t)(tk0 + r) * 2048 + h * 256 + d0 + c8 * 8); }
          __syncthreads();
          { const int d = F.tid >> 3, t8 = F.tid & 7; float f[8];
#pragma unroll
            for (int j = 0; j < 8; ++j) { const int tloc = tk0 + t8 * 8 + j; f[j] = bf2f(tl[(t8 * 8 + j) * 72 + d]) * __builtin_amdgcn_exp2f((float)(255 - (tloc & 255)) * l2g); }
            *(u32x4*)(kdt + ((size_t)(h * 256 + d0 + d)) * 16384 + tk0 + t8 * 8) = pack8(f); }
      }
      __syncthreads(); }
    { SpSched S{(const char*)qcat, (const char*)kbuf, F.G, F.bid};
      EpiSprime E{qcat};
      pg8::gemm_phase(F.lds, S, E); }
}
__device__ __forceinline__ void ph_l1_kv(ArgP ap, const Frame& F_) {
    ap = launder(ap); unsigned char* ws = ap->ws; const Frame F = relaunder(F_);
    KvSched S{(const char*)(ws + WS_VRCAT), (const char*)(ws + WS_KDT), F.G, F.bid};
    EpiUnitPtr E{(bf16_t*)(ws + WS_VRCAT), 512};
    pg8::gemm_phase(F.lds, S, E);
}
__device__ __forceinline__ void ph_l1_rscan(ArgP ap, const Frame& F_) {
    ap = launder(ap); unsigned char* ws = ap->ws; const Frame F = relaunder(F_);
    bf16_t* vrcat = (bf16_t*)(ws + WS_VRCAT);
    for (int v = F.bid * 512 + F.tid; v < 131072; v += F.G * 512) {
        const int h = v >> 14, rem = v & 16383, e = rem >> 5, d8 = rem & 31;
        const float cd = __builtin_amdgcn_exp2f(256.0f * __log2f(1.0f - exp2f(-5.0f - (float)h)));
        bf16_t* p = vrcat + ((size_t)h * 64 * 512 + e) * 512 + 256 + d8 * 8;
        float R[8];
#pragma unroll
        for (int j = 0; j < 8; ++j) R[j] = 0.f;
        for (int n = 0; n < 64; ++n) { bf16_t* q = p + (size_t)n * 512 * 512; float kv[8]; unpack8(*(const u32x4*)q, kv);
            *(u32x4*)q = pack8(R);
#pragma unroll
            for (int j = 0; j < 8; ++j) R[j] = fmaf(cd, R[j], kv[j]); }
    }
}
__device__ __forceinline__ void ph_l1_y(ArgP ap, const Frame& F_) {
    ap = launder(ap); unsigned char* ws = ap->ws; const Frame F = relaunder(F_);
    YSched S{(const char*)(ws + WS_QCAT), (const char*)(ws + WS_VRCAT), F.G, F.bid};
    EpiY E{(bf16_t*)(ws + WS_YB)};
    pg8::gemm_phase(F.lds, S, E);
}
__device__ __forceinline__ void ph_l1_gnorm(ArgP ap, const Frame& F_) {
    ap = launder(ap); unsigned char* ws = ap->ws; const Frame F = relaunder(F_);
    const bf16_t* ybuf1 = (const bf16_t*)(ws + WS_YB); bf16_t* gbuf = (bf16_t*)(ws + WS_GB); const float* od_gn = INP(float, 14);
    for (int it = F.bid * 8 + F.wave; it < 16384 * 8; it += F.G * 8) { const int t = it >> 3, h = it & 7; const size_t off = (size_t)t * 4096 + h * 512 + F.lane * 8;
        float y[8], gg[8]; unpack8(*(const u32x4*)(ybuf1 + off), y); unpack8(*(const u32x4*)(gbuf + off), gg);
        float s = 0.f;
#pragma unroll
        for (int j = 0; j < 8; ++j) s += y[j];
        const float mu = wave_sum(s) * (1.0f / 512.0f); float q = 0.f;
#pragma unroll
        for (int j = 0; j < 8; ++j) { y[j] -= mu; q += y[j] * y[j]; }
        const float rstd = 1.0f / sqrtf(wave_sum(q) * (1.0f / 512.0f) + EPS);
        const f32x4 g0 = *(const f32x4*)(od_gn + h * 512 + F.lane * 8), g1 = *(const f32x4*)(od_gn + h * 512 + F.lane * 8 + 4);
        const float gn[8] = {g0.x, g0.y, g0.z, g0.w, g1.x, g1.y, g1.z, g1.w};
        float o[8];
#pragma unroll
        for (int j = 0; j < 8; ++j) o[j] = gg[j] * (y[j] * rstd * gn[j]);
        *(u32x4*)(gbuf + off) = pack8(o); }
}
__device__ __forceinline__ void ph_l1_out(ArgP ap, const Frame& F_, const int b) {
    ap = launder(ap); unsigned char* ws = ap->ws; const Frame F = relaunder(F_);
    pg8::DenseSched<64, 8, 4096, 4096, 4096> S{(const char*)(ws + WS_GB), (const char*)(ws + WS_WODO), F.G, F.bid};
    EpiResid E{ap->out, ap->out, b * SEQ};
    pg8::gemm_phase(F.lds, S, E);
}
__device__ __forceinline__ void ph_router(ArgP ap, const Frame& F_, const int layer) {
    ap = launder(ap); unsigned char* ws = ap->ws; const Frame F = relaunder(F_);
    if (layer == 1) convert_experts(F, INP(float, 21) + (size_t)32 * 2048 * 512, INP(float, 22) + (size_t)32 * 2048 * 512, INP(float, 23) + (size_t)32 * 512 * 2048, ws);
    const float* xres = ap->out; bf16_t* Hb = (bf16_t*)(ws + WS_H);
    int* CNT = (int*)(ws + SM_CNT); int* ASGE = (int*)(ws + SM_ASGE); int* ASGR = (int*)(ws + SM_ASGR); float* ASGW = (float*)(ws + SM_ASGW);
    const float* gain = INP(float, 16) + layer * D; const float* wgp = INP(float, 17) + (size_t)layer * D * 4; const float* wep = INP(float, 19) + (size_t)layer * D * 32;
    const float* bgp = INP(float, 18) + layer * 4; const float* bep = INP(float, 20) + layer * 32;
    LAS float* xs = (LAS float*)F.lds;
    LAS float* wc = (LAS float*)(F.lds + 128 * 65 * 4);
    LAS float* lg = (LAS float*)(F.lds + 128 * 65 * 4 + 64 * 40 * 4);
    LAS float* rs = lg + 128 * 36;
    LAS int* el = (LAS int*)(rs + 128);
    LAS int* rl = el + 256;
    for (int tile = F.bid; tile < 256; tile += F.G) {
        const int tok0 = tile * 128; const int tl = F.tid & 127, og = F.tid >> 7;
        float accv[9]; float ss = 0.f;
#pragma unroll
        for (int j = 0; j < 9; ++j) accv[j] = 0.f;
        for (int kc = 0; kc < 32; ++kc) {
            __syncthreads();
#pragma unroll
            for (int i = 0; i < 4; ++i) { const int row = (F.tid >> 4) + 32 * i, c4 = (F.tid & 15) * 4; const f32x4 v = *(const f32x4*)(xres + (size_t)(tok0 + row) * D + kc * 64 + c4);
                xs[row * 65 + c4] = v.x; xs[row * 65 + c4 + 1] = v.y; xs[row * 65 + c4 + 2] = v.z; xs[row * 65 + c4 + 3] = v.w; }
            for (int idx = F.tid; idx < 64 * 36; idx += 512) { const int k = idx / 36, o = idx % 36; const int kk = kc * 64 + k;
                wc[k * 40 + o] = gain[kk] * (o < 4 ? wgp[kk * 4 + o] : wep[kk * 32 + (o - 4)]); }
            __syncthreads();
            for (int k = 0; k < 64; ++k) { const float xv = xs[tl * 65 + k]; ss = fmaf(xv, xv, ss);
#pragma unroll
                for (int j = 0; j < 9; ++j) accv[j] = fmaf(xv, wc[k * 40 + og * 9 + j], accv[j]); }
        }
        const float rstd = 1.0f / sqrtf(ss * (1.0f / D) + EPS);
#pragma unroll
        for (int j = 0; j < 9; ++j) { const int o = og * 9 + j; lg[tl * 36 + o] = accv[j] * rstd + (o < 4 ? bgp[o] : bep[o - 4]); }
        if (og == 0) rs[tl] = rstd;
        __syncthreads();
        if (F.tid < 128) {
            const LAS float* q = lg + F.tid * 36;
            int gi = 0; float gm = q[0];
#pragma unroll
            for (int j = 1; j < 4; ++j) if (q[j] > gm) { gm = q[j]; gi = j; }
            float gs = 0.f;
#pragma unroll
            for (int j = 0; j < 4; ++j) gs += __expf(q[j] - gm);
            const float gwt = 1.0f / gs;
            const LAS float* eq = q + 4 + gi * 8;
            int j0 = 0; float m0 = eq[0];
#pragma unroll
            for (int j = 1; j < 8; ++j) if (eq[j] > m0) { m0 = eq[j]; j0 = j; }
            int j1 = -1; float m1v = -3.0e38f;
#pragma unroll
            for (int j = 0; j < 8; ++j) if (j != j0 && eq[j] > m1v) { m1v = eq[j]; j1 = j; }
            const float p1 = __expf(m1v - m0);
            const float w0 = gwt / (1.0f + p1), w1 = gwt * p1 / (1.0f + p1);
            const int tok = tok0 + F.tid;
            el[2 * F.tid] = gi * 8 + j0; el[2 * F.tid + 1] = gi * 8 + j1;
            ASGE[2 * tok] = gi * 8 + j0; ASGE[2 * tok + 1] = gi * 8 + j1; ASGW[2 * tok] = w0; ASGW[2 * tok + 1] = w1;
        }
        __syncthreads();
        if (F.tid < 32) { int c = 0; for (int a = 0; a < 256; ++a) if (el[a] == F.tid) rl[a] = c++; CNT[tile * 32 + F.tid] = c; }
        __syncthreads();
        if (F.tid < 256) ASGR[2 * tok0 + F.tid] = rl[F.tid];
        for (int r = F.wave; r < 128; r += 8) { const float rsd = rs[r]; const f32x4* xr = (const f32x4*)(xres + (size_t)(tok0 + r) * D) + F.lane; const f32x4* gr = (const f32x4*)gain + F.lane;
            u32x2* o8 = (u32x2*)(Hb + (size_t)(tok0 + r) * D) + F.lane;
#pragma unroll
            for (int j = 0; j < 8; ++j) { const f32x4 v = xr[64 * j], g = gr[64 * j]; u32x2 w; w.x = pk2(v.x * rsd * g.x, v.y * rsd * g.y); w.y = pk2(v.z * rsd * g.z, v.w * rsd * g.w); o8[64 * j] = w; } }
    }
    __syncthreads();
}
__device__ __forceinline__ void ph_dispatch(ArgP ap, const Frame& F_) {
    ap = launder(ap); unsigned char* ws = ap->ws; const Frame F = relaunder(F_);
    int* CNT = (int*)(ws + SM_CNT); int* TT = (int*)(ws + SM_TT); int* ASGE = (int*)(ws + SM_ASGE); int* ASGR = (int*)(ws + SM_ASGR); int* DEST = (int*)(ws + SM_DEST); int* ROWTOK = (int*)(ws + SM_ROWTOK);
    LAS int* cl = (LAS int*)F.lds;
    LAS int* tot = cl + 256 * 32;
    LAS int* tstart = tot + 32;
    LAS int* base = tstart + 32;
    __syncthreads();
    for (int idx = F.tid; idx < 256 * 32; idx += 512) cl[idx] = CNT[idx];
    __syncthreads();
    if (F.tid < 32) { int s = 0; for (int w2 = 0; w2 < 256; ++w2) s += cl[w2 * 32 + F.tid]; tot[F.tid] = s; }
    __syncthreads();
    if (F.tid == 0) { int acc2 = 0; for (int e = 0; e < 32; ++e) { tstart[e] = acc2; acc2 += (tot[e] + 255) >> 8; }
        if (F.bid == 0) { TT[0] = acc2; for (int e = 0; e < 32; ++e) { const int n = (tot[e] + 255) >> 8; for (int i = 0; i < n; ++i) TT[1 + tstart[e] + i] = e; } } }
    __syncthreads();
    for (int tile = F.bid; tile < 256; tile += F.G) {
        if (F.tid < 32) { int s = 0; for (int w2 = 0; w2 < tile; ++w2) s += cl[w2 * 32 + F.tid]; base[F.tid] = s; }
        __syncthreads();
        if (F.tid < 256) { const int a = 2 * tile * 128 + F.tid; const int e = ASGE[a]; const int pos = tstart[e] * 256 + base[e] + ASGR[a]; DEST[a] = pos; ROWTOK[pos] = a >> 1; }
        __syncthreads();
    }
    for (int e = F.bid; e < 32; e += F.G) { const int n = (tot[e] + 255) >> 8; for (int p = tot[e] + F.tid; p < n * 256; p += 512) ROWTOK[tstart[e] * 256 + p] = 0; }
    __syncthreads();
}
__device__ __forceinline__ void ph_moe1(ArgP ap, const Frame& F_) {
    ap = launder(ap); unsigned char* ws = ap->ws; const Frame F = relaunder(F_);
    const int* TT = (const int*)(ws + SM_TT);
    LAS int* tt = (LAS int*)(F.lds + LDS_TT);
    __syncthreads();
    for (int idx = F.tid; idx < 1 + NRT_MAX; idx += 512) tt[idx] = TT[idx];
    __syncthreads();
    Moe1Sched S{(const char*)(ws + WS_H), (const char*)(ws + WS_WGU), (const int*)(ws + SM_ROWTOK), tt, F.G, F.bid};
    EpiSwiGLU E{(bf16_t*)(ws + WS_HID)};
    pg8::gemm_phase(F.lds, S, E);
}
__device__ __forceinline__ void ph_moe2(ArgP ap, const Frame& F_) {
    ap = launder(ap); unsigned char* ws = ap->ws; const Frame F = relaunder(F_);
    const int* TT = (const int*)(ws + SM_TT);
    LAS int* tt = (LAS int*)(F.lds + LDS_TT);
    __syncthreads();
    for (int idx = F.tid; idx < 1 + NRT_MAX; idx += 512) tt[idx] = TT[idx];
    __syncthreads();
    Moe2Sched S{(const char*)(ws + WS_HID), (const char*)(ws + WS_WD), tt, F.G, F.bid};
    EpiPlain E{(bf16_t*)(ws + WS_YBUF), 2048, (size_t)256 * 2048, 256};
    pg8::gemm_phase(F.lds, S, E);
}
__device__ __forceinline__ void ph_combine(ArgP ap, const Frame& F_, const int layer) {
    ap = launder(ap); unsigned char* ws = ap->ws; const Frame F = relaunder(F_);
    const bf16_t* yb = (const bf16_t*)(ws + WS_YBUF); float* xres = ap->out; bf16_t* Hb = (bf16_t*)(ws + WS_H);
    const int* DEST = (const int*)(ws + SM_DEST); const float* ASGW = (const float*)(ws + SM_ASGW);
    const float* gain = layer == 0 ? INP(float, 12) : INP(float, 24);
    for (int m = F.bid * 8 + F.wave; m < T; m += F.G * 8) {
        const int d0 = DEST[2 * m], d1 = DEST[2 * m + 1]; const float w0 = ASGW[2 * m], w1 = ASGW[2 * m + 1];
        f32x4* xr = (f32x4*)(xres + (size_t)m * D) + F.lane; const f32x4* gr = (const f32x4*)gain + F.lane;
        const u32x2* y0p = (const u32x2*)(yb + (size_t)d0 * D) + F.lane; const u32x2* y1p = (const u32x2*)(yb + (size_t)d1 * D) + F.lane;
        f32x4 v[8]; float s = 0.f;
#pragma unroll
        for (int j = 0; j < 8; ++j) { const f32x4 xv = xr[64 * j]; const u32x2 a = y0p[64 * j], c = y1p[64 * j];
            v[j].x = xv.x + w0 * bf_lo(a.x) + w1 * bf_lo(c.x); v[j].y = xv.y + w0 * bf_hi(a.x) + w1 * bf_hi(c.x);
            v[j].z = xv.z + w0 * bf_lo(a.y) + w1 * bf_lo(c.y); v[j].w = xv.w + w0 * bf_hi(a.y) + w1 * bf_hi(c.y);
            s += (v[j].x * v[j].x + v[j].y * v[j].y) + (v[j].z * v[j].z + v[j].w * v[j].w); }
        const float rstd = 1.0f / sqrtf(wave_sum(s) * (1.0f / D) + EPS);
        if (layer == 0) {
            u32x2* o8 = (u32x2*)(Hb + (size_t)m * D) + F.lane;
#pragma unroll
            for (int j = 0; j < 8; ++j) { xr[64 * j] = v[j]; const f32x4 g = gr[64 * j]; u32x2 w; w.x = pk2(v[j].x * rstd * g.x, v[j].y * rstd * g.y); w.y = pk2(v[j].z * rstd * g.z, v[j].w * rstd * g.w); o8[64 * j] = w; }
        } else {
#pragma unroll
            for (int j = 0; j < 8; ++j) { const f32x4 g = gr[64 * j]; f32x4 o; o.x = v[j].x * rstd * g.x; o.y = v[j].y * rstd * g.y; o.z = v[j].z * rstd * g.z; o.w = v[j].w * rstd * g.w; xr[64 * j] = o; }
        }
    }
}

#ifndef PH_MASK
#define PH_MASK 0xffffffffull
#endif
#define SITE(s) ((PH_MASK >> (s)) & 1ull)
__global__ void __launch_bounds__(512, 2) mk_fwd(Args args) {
    extern __shared__ __attribute__((aligned(16))) unsigned char lds_raw[];
    ArgP ap = (ArgP)__builtin_amdgcn_kernarg_segment_ptr();
    Frame F;
    F.lds = (LAS unsigned char*)lds_raw;
    F.tid = threadIdx.x; F.lane = F.tid & 63; F.wave = __builtin_amdgcn_readfirstlane(F.tid >> 6); F.G = gridDim.x; F.bid = blockIdx.x;
    volatile LAS unsigned* MISC = (volatile LAS unsigned*)(F.lds + LDS_MISC);
    if (F.tid < 64) MISC[F.tid] = 0u;
    __syncthreads();
    const int lo = ap->ph_lo, hi = ap->ph_hi;
    XcdBarrier bar = xcd_barrier_post((unsigned*)(ap->ws + WS_CTL) + CW_BAR + ap->li * XCD_BAR_WORDS, MISC + 8);
#define IN(k) (SITE(k) && lo <= (k) && (k) < hi)
#define SEAM(k) do { if ((k) + 1 < hi) xcd_barrier(bar); } while (0)
    if (IN(0)) { ph_prologue(ap, F); SEAM(0); }
    if (IN(1)) { ph_inproj0(ap, F); SEAM(1); }
    if (IN(2)) { ph_conv_attn(ap, F); SEAM(2); }
    if (IN(3)) { ph_gates(ap, F); SEAM(3); }
    if (IN(4)) { ph_scan(ap, F, 0); SEAM(4); }
    if (IN(5)) { ph_scan(ap, F, 1); SEAM(5); }
    if (IN(6)) { ph_outproj0(ap, F); SEAM(6); }
#define MOE_HALF(layer, p0) \
    if (IN((p0) + 0)) { ph_router(ap, F, layer); SEAM((p0) + 0); } \
    if (IN((p0) + 1)) { ph_dispatch(ap, F); SEAM((p0) + 1); } \
    if (IN((p0) + 2)) { ph_moe1(ap, F); SEAM((p0) + 2); } \
    if (IN((p0) + 3)) { ph_moe2(ap, F); SEAM((p0) + 3); } \
    if (IN((p0) + 4)) { ph_combine(ap, F, layer); SEAM((p0) + 4); }
#define L1_MIXER(b, p0) \
    if (IN((p0) + 0)) { ph_l1_inproj(ap, F, b); SEAM((p0) + 0); } \
    if (IN((p0) + 1)) { ph_l1_kt_sp(ap, F); SEAM((p0) + 1); } \
    if (IN((p0) + 2)) { ph_l1_kv(ap, F); SEAM((p0) + 2); } \
    if (IN((p0) + 3)) { ph_l1_rscan(ap, F); SEAM((p0) + 3); } \
    if (IN((p0) + 4)) { ph_l1_y(ap, F); SEAM((p0) + 4); } \
    if (IN((p0) + 5)) { ph_l1_gnorm(ap, F); SEAM((p0) + 5); } \
    if (IN((p0) + 6)) { ph_l1_out(ap, F, b); SEAM((p0) + 6); }
    MOE_HALF(0, 7)
    L1_MIXER(0, 12)
    L1_MIXER(1, 19)
    MOE_HALF(1, 26)
#undef MOE_HALF
#undef L1_MIXER
#undef IN
#undef SEAM
}

constexpr int N_PHASES = 31;
#ifndef MK_PER_PHASE
#define MK_PER_PHASE 0
#endif
extern "C" void kernel_launch(void* const* d_in, const int* in_sizes, int n_in, void* d_out, int out_size, void* d_ws, size_t ws_size, hipStream_t stream) {
    static int grid = 0;
    if (grid == 0) {
        if (n_in != 25 || out_size != T * D || ws_size < WS_END) { fprintf(stderr, "kernel_launch: unexpected shapes (n_in %d out %d ws %zu)\n", n_in, out_size, ws_size); grid = -1; return; }
        int dev = 0, cus = 0, per_cu = 0;
        if (hipGetDevice(&dev) != hipSuccess || hipDeviceGetAttribute(&cus, hipDeviceAttributeMultiprocessorCount, dev) != hipSuccess) { grid = -1; return; }
        if (hipFuncSetAttribute((const void*)mk_fwd, hipFuncAttributeMaxDynamicSharedMemorySize, LDS_BYTES) != hipSuccess) { fprintf(stderr, "kernel_launch: hipFuncSetAttribute failed\n"); grid = -1; return; }
        if (hipOccupancyMaxActiveBlocksPerMultiprocessor(&per_cu, (const void*)mk_fwd, 512, LDS_BYTES) != hipSuccess || per_cu < 1) fprintf(stderr, "kernel_launch: occupancy query reports %d\n", per_cu);
        (void)hipGetLastError();
        grid = cus;
    }
    if (grid < 0) return;
    (void)hipMemsetAsync((char*)d_ws + WS_CTL, 0, CTL_ZERO_BYTES, stream);
    Args a; memset(&a, 0, sizeof(a));
    for (int i = 0; i < 25; ++i) a.in[i] = d_in[i];
    a.out = (float*)d_out; a.ws = (unsigned char*)d_ws;
#if MK_PER_PHASE
    for (int p = 0; p < N_PHASES; ++p) { a.ph_lo = p; a.ph_hi = p + 1; a.li = 0; hipLaunchKernelGGL(mk_fwd, dim3(grid), dim3(512), LDS_BYTES, stream, a); }
#else
    a.ph_lo = 0; a.ph_hi = N_PHASES; a.li = 0;
    hipLaunchKernelGGL(mk_fwd, dim3(grid), dim3(512), LDS_BYTES, stream, a);
#endif
}
```

```cpp
#include <hip/hip_runtime.h>
#include <cstdio>
#include <cstdint>
#include <cstring>

#define LAS __attribute__((address_space(3)))
#define GAS __attribute__((address_space(1)))
typedef unsigned short bf16_t;
typedef short bf16x8 __attribute__((ext_vector_type(8)));
typedef float f32x4 __attribute__((ext_vector_type(4)));
typedef float f32x2 __attribute__((ext_vector_type(2)));
typedef unsigned u32x4 __attribute__((ext_vector_type(4)));
typedef unsigned u32x2 __attribute__((ext_vector_type(2)));

constexpr int T = 32768, D = 2048, SEQ = 16384;
constexpr int EV_IN = 5120, OD_IN = 12288;
constexpr int PMAX = 65536 + 32 * 256, NRT_MAX = PMAX / 256;
constexpr float EPS = 1e-6f;

constexpr size_t MiB = 1u << 20;
constexpr size_t WS_CTL = 0, CTL_ZERO_BYTES = 1 * MiB;
constexpr size_t WS_SMALL = 1 * MiB;
constexpr size_t SM_CNT = WS_SMALL + 0;
constexpr size_t SM_TT = WS_SMALL + 32 * 1024;
constexpr size_t SM_ASGE = WS_SMALL + 64 * 1024;
constexpr size_t SM_ASGR = WS_SMALL + 320 * 1024;
constexpr size_t SM_ASGW = WS_SMALL + 576 * 1024;
constexpr size_t SM_DEST = WS_SMALL + 832 * 1024;
constexpr size_t SM_ROWTOK = WS_SMALL + 1088 * 1024;
constexpr size_t WS_ROT = 4 * MiB;
constexpr size_t WS_WOD = 36 * MiB;
constexpr size_t WS_WODO = 84 * MiB;
constexpr size_t WS_WGU = 100 * MiB;
constexpr size_t WS_WD = 228 * MiB;
constexpr size_t WS_WEVI = 292 * MiB;
constexpr size_t WS_WEVO = 312 * MiB;
constexpr size_t WS_WGATE = 320 * MiB;
constexpr size_t WS_SUB = 321 * MiB;
constexpr size_t WS_CH = 329 * MiB;
constexpr size_t WS_H = 332 * MiB;
constexpr size_t ARENA = 460 * MiB;
constexpr size_t WS_PROJ0 = ARENA;
constexpr size_t WS_XC = 780 * MiB;
constexpr size_t WS_GPRE = 844 * MiB;
constexpr size_t WS_Y0 = 972 * MiB;
constexpr size_t WS_HID = ARENA;
constexpr size_t WS_YBUF = 532 * MiB;
constexpr size_t WS_QCAT = ARENA;
constexpr size_t WS_VRCAT = 588 * MiB;
constexpr size_t WS_KB = 844 * MiB;
constexpr size_t WS_KDT = 908 * MiB;
constexpr size_t WS_YB = 844 * MiB;
constexpr size_t WS_GB = 972 * MiB;
constexpr size_t WS_STATS = 292 * MiB;
constexpr size_t WS_END = 1100 * MiB;

constexpr int CW_BAR = 4096;

constexpr int LDS_MAIN = 131072;
constexpr int LDS_MISC = LDS_MAIN;
constexpr int LDS_TT = LDS_MAIN + 256;
constexpr int LDS_BYTES = 147456;

__device__ __forceinline__ unsigned f2bf(float f) { unsigned u = __builtin_bit_cast(unsigned, f); return (u + 0x7fffu + ((u >> 16) & 1u)) >> 16; }
__device__ __forceinline__ unsigned pk2(float lo, float hi) { unsigned r; asm volatile("v_cvt_pk_bf16_f32 %0, %1, %2" : "=v"(r) : "v"(lo), "v"(hi)); return r; }
__device__ __forceinline__ float bf_lo(unsigned w) { return __builtin_bit_cast(float, w << 16); }
__device__ __forceinline__ float bf_hi(unsigned w) { return __builtin_bit_cast(float, w & 0xffff0000u); }
__device__ __forceinline__ float bf2f(bf16_t h) { return __builtin_bit_cast(float, ((unsigned)h) << 16); }
__device__ __forceinline__ float wave_sum(float v) {
#pragma unroll
    for (int o = 1; o < 64; o <<= 1) v += __shfl_xor(v, o);
    return v;
}
__device__ __forceinline__ float sigmoidf_(float x) { return __builtin_amdgcn_rcpf(1.0f + __expf(-x)); }
__device__ __forceinline__ float gelu_tanh(float x) { const float u = 0.7978845608028654f * (x + 0.044715f * x * x * x); const float e = __expf(2.0f * u); const float th = 1.0f - 2.0f * __builtin_amdgcn_rcpf(e + 1.0f); return 0.5f * x * (1.0f + th); }
__device__ __forceinline__ void unpack8(const u32x4 w, float (&f)[8]) { f[0] = bf_lo(w.x); f[1] = bf_hi(w.x); f[2] = bf_lo(w.y); f[3] = bf_hi(w.y); f[4] = bf_lo(w.z); f[5] = bf_hi(w.z); f[6] = bf_lo(w.w); f[7] = bf_hi(w.w); }
__device__ __forceinline__ u32x4 pack8(const float (&f)[8]) { u32x4 w; w.x = pk2(f[0], f[1]); w.y = pk2(f[2], f[3]); w.z = pk2(f[4], f[5]); w.w = pk2(f[6], f[7]); return w; }
#define LDS_WAIT() asm volatile("s_waitcnt lgkmcnt(0)" ::: "memory")

#define XB_TMO      128
#define XB_XCNT(j)  (256  + 64 * (j))
#define XB_XSUB(j)  (1280 + 64 * (j))
#define XB_XGEN(j)  (2304 + 64 * (j))
#define XB_TOP      3328
#define XB_TOPGEN   3392
#define XCD_BAR_WORDS 3456
#define XB_SPIN_CAP (1u << 18)
__device__ __forceinline__ unsigned xb_ld(unsigned* p)              { return __hip_atomic_load(p, __ATOMIC_RELAXED, __HIP_MEMORY_SCOPE_AGENT); }
__device__ __forceinline__ unsigned xb_add(unsigned* p, unsigned v) { return __hip_atomic_fetch_add(p, v, __ATOMIC_RELAXED, __HIP_MEMORY_SCOPE_AGENT); }
__device__ __forceinline__ unsigned xb_xcc_id() { return (unsigned)__builtin_amdgcn_s_getreg((3 << 11) | 20) & 0xFu; }
#define XB_SPIN(cond, bar) do { unsigned _sp = 0; while (cond) { __builtin_amdgcn_s_sleep(1); \
    if ((++_sp & 255u) == 0u) { if (xb_ld(&(bar)[XB_TMO])) break; if (_sp > XB_SPIN_CAP) { atomicAdd(&(bar)[XB_TMO], 1u); break; } } } } while (0)
struct XcdBarrier { unsigned* bar; unsigned x; volatile LAS unsigned* st; };
__device__ __forceinline__ XcdBarrier xcd_barrier_post(unsigned* bar, volatile LAS unsigned* st) {
    XcdBarrier b; b.bar = bar; b.x = xb_xcc_id(); b.st = st;
    if (threadIdx.x == 0) (void)xb_add(&bar[XB_XCNT(b.x)], 1u);
    return b;
}
__device__ __forceinline__ void xcd_barrier_complete(unsigned* bar, unsigned x, unsigned& nloc, unsigned& nx) {
    const unsigned G = gridDim.x * gridDim.y * gridDim.z;
    unsigned sum, cnt, mine, sp = 0u;
    for (;;) {
        sum = 0u; cnt = 0u; mine = 0u;
#pragma unroll
        for (unsigned j = 0; j < 16; ++j) { const unsigned c = xb_ld(&bar[XB_XCNT(j)]); sum += c; cnt += (c > 0u) ? 1u : 0u; mine = (j == x) ? c : mine; }
        if (sum == G) break;
        __builtin_amdgcn_s_sleep(1);
        if ((++sp & 255u) == 0u) { if (xb_ld(&bar[XB_TMO])) break; if (sp > XB_SPIN_CAP) { atomicAdd(&bar[XB_TMO], 1u); break; } }
    }
    nloc = mine > 0u ? mine : 1u; nx = cnt > 0u ? cnt : 1u;
}
__device__ __forceinline__ void xcd_barrier(const XcdBarrier& b) {
    asm volatile("s_waitcnt vmcnt(0)" ::: "memory");
    __syncthreads();
    if (threadIdx.x == 0) {
        unsigned* bar = b.bar;
        __builtin_amdgcn_s_waitcnt(0);
        unsigned nloc = b.st[0], nx = b.st[1];
        if (nloc == 0u) { xcd_barrier_complete(bar, b.x, nloc, nx); b.st[0] = nloc; b.st[1] = nx; }
        const unsigned old = xb_add(&bar[XB_XSUB(b.x)], 1u);
        const unsigned gen = old / nloc;
        if (old + 1u == (gen + 1u) * nloc) {
            __builtin_amdgcn_fence(__ATOMIC_RELEASE, "agent");
            asm volatile("s_waitcnt vmcnt(0)" ::: "memory");
            const unsigned og = xb_add(&bar[XB_TOP], 1u);
            const unsigned tg = og / nx;
            if (og + 1u == (tg + 1u) * nx) xb_add(&bar[XB_TOPGEN], 1u);
            else XB_SPIN(xb_ld(&bar[XB_TOPGEN]) == tg, bar);
            __builtin_amdgcn_fence(__ATOMIC_ACQUIRE, "agent");
            xb_add(&bar[XB_XGEN(b.x)], 1u);
            asm volatile("s_waitcnt vmcnt(0)" ::: "memory");
        } else {
            XB_SPIN(xb_ld(&bar[XB_XGEN(b.x)]) == gen, bar);
            __builtin_amdgcn_fence(__ATOMIC_ACQUIRE, "agent");
            asm volatile("s_waitcnt vmcnt(0)" ::: "memory");
        }
    }
    __syncthreads();
}

namespace pg8 {
constexpr int BM = 256, BK = 64, HALF = 128, HTB = HALF * BK * 2, STAGE_BYTES = 8 * HTB, NXCD = 8, WGM = 8;
__device__ __forceinline__ int lds_byte(int r, int c) { const int st = (r >> 4) * 2 + (c >> 5), rr = r & 15, cc = c & 31, ob = rr * 64 + cc * 2; return st * 1024 + (ob ^ (((ob >> 9) & 1) << 5)); }
__device__ __forceinline__ void stage_rc(int b, int& R, int& C) { const int st = b / 1024, sb = b % 1024, swz = sb ^ (((sb >> 9) & 1) << 5); R = (st >> 1) * 16 + swz / 64; C = (st & 1) * 32 + (swz % 64) / 2; }
__device__ __forceinline__ int perm32(int rho) { const int n = rho >> 4, i = rho & 15; return 8 * (i >> 2) + 4 * n + (i & 3); }

struct Unit { const char* a; const char* b; int pm, pn, x0, x1; };

__device__ __forceinline__ void tile_order(int L, int nM, int nN, int& pm, int& pn) {
    const int nwg = nM * nN; int wgid = L;
    { const int q = nwg / NXCD, r = nwg % NXCD, xcd = wgid % NXCD, off = wgid / NXCD; wgid = (xcd < r ? xcd * (q + 1) : r * (q + 1) + (xcd - r) * q) + off; }
    const int nig = WGM * nN, gid = wgid / nig, fm = gid * WGM, gsz = (nM - fm) < WGM ? (nM - fm) : WGM;
    pm = fm + ((wgid % nig) % gsz); pn = (wgid % nig) / gsz;
}

template <class Epi, class Sched>
__device__ __forceinline__ void gemm_phase(LAS unsigned char* lds, const Sched& S, const Epi& E) {
    int tid_ = threadIdx.x; asm volatile("" : "+v"(tid_));
    const int tid = tid_, wid = __builtin_amdgcn_readfirstlane(tid >> 6), lane = tid & 63, wr = wid >> 2, wc = wid & 3, fr = lane & 15, fq = lane >> 4;
    const int nt = S.K / BK;
    int sR[2], sC[2];
    unsigned voffB[2];
#pragma unroll
    for (int i = 0; i < 2; ++i) { stage_rc(tid * 16 + i * 8192, sR[i], sC[i]); const int Rb = Epi::PERM ? ((sR[i] & ~31) + perm32(sR[i] & 31)) : sR[i];
        voffB[i] = (unsigned)(Rb * S.ldb + sC[i]) * 2u; }
    const size_t kstep = (size_t)(BK * 2);
    const size_t hstepB = (size_t)HALF * S.ldb * 2, hstepA = (size_t)HALF * S.lda * 2;
    const unsigned ldsw = (unsigned)wid * 1024u;
    const int aoff = lds_byte(wr * 64 + fr, fq * 8), boff = lds_byte(wc * 32 + fr, fq * 8);
#define PG8_SA(b, h) (((b) * 2 + (h)) * HTB)
#define PG8_SB(b, h) ((4 + (b) * 2 + (h)) * HTB)
#define PG8_STAGE2(bufoff, gbase, v0, v1) do { \
        __builtin_amdgcn_global_load_lds((const unsigned*)((const char*)(gbase) + (v0)), (LAS unsigned*)(lds + (bufoff) + ldsw), 16, 0, 0); \
        __builtin_amdgcn_global_load_lds((const unsigned*)((const char*)(gbase) + (v1)), (LAS unsigned*)(lds + (bufoff) + ldsw + 8192), 16, 0, 0); } while (0)
#define PG8_STAGEB(b, h, gbase) PG8_STAGE2(PG8_SB(b, h), (gbase) + (h) * hstepB, voffB[0], voffB[1])
#define PG8_STAGEA(b, h, gbase, V) do { if constexpr (Sched::GATHER) { PG8_STAGE2(PG8_SA(b, h), gbase, V[h][0], V[h][1]); } else { PG8_STAGE2(PG8_SA(b, h), (gbase) + (h) * hstepA, V[0][0], V[0][1]); } } while (0)
#define PG8_LDA(dst, b, h) do { _Pragma("unroll") for (int m = 0; m < 4; ++m) _Pragma("unroll") for (int k = 0; k < 2; ++k) dst[m][k] = *(const LAS bf16x8*)(lds + PG8_SA(b, h) + aoff + m * 2048 + k * 1024); } while (0)
#define PG8_LDB(dst, b, h) do { _Pragma("unroll") for (int n = 0; n < 2; ++n) _Pragma("unroll") for (int k = 0; k < 2; ++k) dst[n][k] = *(const LAS bf16x8*)(lds + PG8_SB(b, h) + boff + n * 2048 + k * 1024); } while (0)
#define PG8_MMA(ai, bj, At, Bt) do { __builtin_amdgcn_s_setprio(1); _Pragma("unroll") for (int m = 0; m < 4; ++m) _Pragma("unroll") for (int n = 0; n < 2; ++n) _Pragma("unroll") for (int k = 0; k < 2; ++k) \
        acc[ai][bj][m][n] = __builtin_amdgcn_mfma_f32_16x16x32_bf16(Bt[n][k], At[m][k], acc[ai][bj][m][n], 0, 0, 0); __builtin_amdgcn_s_setprio(0); } while (0)
#define PG8_WAIT_V(n) asm volatile("s_waitcnt vmcnt(" #n ")" ::: "memory")
#define PG8_WAIT_L(n) asm volatile("s_waitcnt lgkmcnt(" #n ")" ::: "memory")
#define PG8_BAR __builtin_amdgcn_s_barrier()
#define PG8_SCHED __builtin_amdgcn_sched_barrier(0)
#define PG8_CALC_VA(u, V) do { _Pragma("unroll") for (int _h = 0; _h < 2; ++_h) _Pragma("unroll") for (int _i = 0; _i < 2; ++_i) { \
        if constexpr (Sched::GATHER) V[_h][_i] = S.row_off(u, sR[_i] + HALF * _h) + (unsigned)sC[_i] * 2u; \
        else V[_h][_i] = (unsigned)((sR[_i] + HALF * _h) * S.lda + sC[_i]) * 2u; } } while (0)
    Unit cur, nxt; int ui = 0;
    if (!S.next(0, cur)) return;
    f32x4 acc[2][2][4][2];
#pragma unroll
    for (int a = 0; a < 2; ++a)
#pragma unroll
        for (int b = 0; b < 2; ++b)
#pragma unroll
            for (int m = 0; m < 4; ++m)
#pragma unroll
                for (int n = 0; n < 2; ++n) acc[a][b][m][n] = (f32x4){0.f, 0.f, 0.f, 0.f};
    bf16x8 At[4][2], B0[2][2], B1[2][2];
    unsigned vA[2][2], vN[2][2];
    PG8_CALC_VA(cur, vA);
    const char* cA = cur.a; const char* cB = cur.b;
    PG8_STAGEB(0, 0, cB); PG8_STAGEB(0, 1, cB); PG8_STAGEA(0, 0, cA, vA); PG8_STAGEA(0, 1, cA, vA);
    if (wr == 1) PG8_BAR;
    PG8_WAIT_V(2); PG8_BAR;
    PG8_STAGEB(1, 0, cB + kstep); PG8_STAGEA(1, 0, cA + kstep, vA); PG8_STAGEB(1, 1, cB + kstep);
    PG8_WAIT_V(6); PG8_BAR;
    for (;;) {
        const bool has_next = S.next(ui + 1, nxt);
        const char* nA = has_next ? nxt.a : cA; const char* nB = has_next ? nxt.b : cB;
        if constexpr (Sched::GATHER) { if (has_next) { PG8_CALC_VA(nxt, vN); } else {
#pragma unroll
            for (int _h = 0; _h < 2; ++_h)
#pragma unroll
                for (int _i = 0; _i < 2; ++_i) vN[_h][_i] = vA[_h][_i]; } }
#pragma unroll 1
        for (int t = 0; t < nt; t += 2) {
            const bool last = (t == nt - 2);
            const char* a1 = cA + (size_t)(t + 1) * kstep;
            const char* a2 = last ? nA : cA + (size_t)(t + 2) * kstep; const char* b2 = last ? nB : cB + (size_t)(t + 2) * kstep;
            const char* a3 = a2 + kstep; const char* b3 = b2 + kstep;
            unsigned vS[2][2];
#pragma unroll
            for (int _h = 0; _h < 2; ++_h)
#pragma unroll
                for (int _i = 0; _i < 2; ++_i) { if constexpr (Sched::GATHER) vS[_h][_i] = last ? vN[_h][_i] : vA[_h][_i]; else vS[_h][_i] = vA[_h][_i]; }
            PG8_LDB(B0, 0, 0); PG8_LDB(B1, 0, 1); PG8_SCHED; PG8_LDA(At, 0, 0); PG8_STAGEA(1, 1, a1, vA);
            PG8_WAIT_V(8); PG8_WAIT_L(0); PG8_BAR; PG8_MMA(0, 0, At, B0); PG8_MMA(0, 1, At, B1); PG8_BAR; PG8_SCHED;
            PG8_LDA(At, 0, 1); PG8_STAGEB(0, 0, b2); PG8_STAGEB(0, 1, b2); PG8_STAGEA(0, 0, a2, vS);
            PG8_WAIT_V(8); PG8_WAIT_L(0); PG8_BAR; PG8_MMA(1, 0, At, B0); PG8_MMA(1, 1, At, B1); PG8_BAR; PG8_SCHED;
            PG8_LDB(B0, 1, 0); PG8_LDB(B1, 1, 1); PG8_SCHED; PG8_LDA(At, 1, 0); PG8_STAGEA(0, 1, a2, vS);
            PG8_WAIT_V(8); PG8_WAIT_L(0); PG8_BAR; PG8_MMA(0, 0, At, B0); PG8_MMA(0, 1, At, B1); PG8_BAR; PG8_SCHED;
            PG8_LDA(At, 1, 1); PG8_STAGEB(1, 0, b3); PG8_STAGEB(1, 1, b3); PG8_STAGEA(1, 0, a3, vS);
            PG8_WAIT_V(8); PG8_WAIT_L(0); PG8_BAR; PG8_MMA(1, 0, At, B0); PG8_MMA(1, 1, At, B1); PG8_BAR; PG8_SCHED;
        }
        if (wr == 0) PG8_BAR;
        E(acc, cur, wr, wc, fr, fq);
        if (!has_next) break;
#pragma unroll
        for (int a = 0; a < 2; ++a)
#pragma unroll
            for (int b = 0; b < 2; ++b)
#pragma unroll
                for (int m = 0; m < 4; ++m)
#pragma unroll
                    for (int n = 0; n < 2; ++n) acc[a][b][m][n] = (f32x4){0.f, 0.f, 0.f, 0.f};
        cur = nxt; cA = nA; cB = nB; ++ui;
        if constexpr (Sched::GATHER) {
#pragma unroll
            for (int _h = 0; _h < 2; ++_h)
#pragma unroll
                for (int _i = 0; _i < 2; ++_i) vA[_h][_i] = vN[_h][_i]; }
        if (wr == 1) PG8_BAR;
    }
    PG8_WAIT_V(0);
    PG8_BAR;
#undef PG8_SA
#undef PG8_SB
#undef PG8_STAGE2
#undef PG8_STAGEA
#undef PG8_STAGEB
#undef PG8_LDA
#undef PG8_LDB
#undef PG8_MMA
#undef PG8_WAIT_V
#undef PG8_WAIT_L
#undef PG8_BAR
#undef PG8_SCHED
#undef PG8_CALC_VA
}

template <int nM, int nN, int LDA, int LDB, int KK>
struct DenseSched {
    static constexpr bool GATHER = false;
    static constexpr int K = KK, lda = LDA, ldb = LDB;
    const char* A; const char* B; int G, c;
    __device__ __forceinline__ bool next(int i, Unit& u) const {
        const int L = i * G + c; if (L >= nM * nN) return false;
        int pm, pn; tile_order(L, nM, nN, pm, pn);
        u.pm = pm; u.pn = pn; u.x0 = 0; u.x1 = 0; u.a = A + (size_t)pm * BM * lda * 2; u.b = B + (size_t)pn * BM * ldb * 2; return true;
    }
    __device__ __forceinline__ unsigned row_off(const Unit&, int) const { return 0u; }
};
}

typedef const f32x4 (&AccRef)[2][2][4][2];

struct EpiPlain {
    static constexpr bool PERM = true;
    bf16_t* out; int ldc; size_t pm_stride, pn_stride;
    __device__ __forceinline__ void operator()(AccRef acc, const pg8::Unit& u, int wr, int wc, int fr, int fq) const {
        bf16_t* tile = out + (size_t)u.pm * pm_stride + (size_t)u.pn * pn_stride;
        int r0 = wr * 64 + fr, c0 = wc * 32 + 8 * fq; asm volatile("" : "+v"(r0), "+v"(c0));
#pragma unroll
        for (int ai = 0; ai < 2; ++ai)
#pragma unroll
            for (int m = 0; m < 4; ++m) { bf16_t* rowp = tile + (size_t)(r0 + ai * 128 + m * 16) * ldc + c0;
#pragma unroll
                for (int bj = 0; bj < 2; ++bj) { const f32x4 v0 = acc[ai][bj][m][0], v1 = acc[ai][bj][m][1];
                    u32x4 w; w.x = pk2(v0[0], v0[1]); w.y = pk2(v0[2], v0[3]); w.z = pk2(v1[0], v1[1]); w.w = pk2(v1[2], v1[3]);
                    *(u32x4*)(rowp + bj * 128) = w; } }
    }
};
struct EpiUnitPtr {
    static constexpr bool PERM = true;
    bf16_t* out; int ldc;
    __device__ __forceinline__ void operator()(AccRef acc, const pg8::Unit& u, int wr, int wc, int fr, int fq) const {
        bf16_t* tile = out + (((size_t)(unsigned)u.x1 << 32) | (size_t)(unsigned)u.x0);
        int r0 = wr * 64 + fr, c0 = wc * 32 + 8 * fq; asm volatile("" : "+v"(r0), "+v"(c0));
#pragma unroll
        for (int ai = 0; ai < 2; ++ai)
#pragma unroll
            for (int m = 0; m < 4; ++m) { bf16_t* rowp = tile + (size_t)(r0 + ai * 128 + m * 16) * ldc + c0;
#pragma unroll
                for (int bj = 0; bj < 2; ++bj) { const f32x4 v0 = acc[ai][bj][m][0], v1 = acc[ai][bj][m][1];
                    u32x4 w; w.x = pk2(v0[0], v0[1]); w.y = pk2(v0[2], v0[3]); w.z = pk2(v1[0], v1[1]); w.w = pk2(v1[2], v1[3]);
                    *(u32x4*)(rowp + bj * 128) = w; } }
    }
};
struct EpiResid {
    static constexpr bool PERM = false;
    const float* base; float* out; int row0;
    __device__ __forceinline__ void operator()(AccRef acc, const pg8::Unit& u, int wr, int wc, int fr, int fq) const {
        int r0 = row0 + u.pm * 256 + wr * 64 + fr, c0 = u.pn * 256 + wc * 32 + 4 * fq; asm volatile("" : "+v"(r0), "+v"(c0));
#pragma unroll
        for (int ai = 0; ai < 2; ++ai)
#pragma unroll
            for (int m = 0; m < 4; ++m) { const size_t off = (size_t)(r0 + ai * 128 + m * 16) * D + c0;
#pragma unroll
                for (int bj = 0; bj < 2; ++bj)
#pragma unroll
                    for (int n = 0; n < 2; ++n) { const f32x4 bs = *(const f32x4*)(base + off + bj * 128 + n * 16); *(f32x4*)(out + off + bj * 128 + n * 16) = bs + acc[ai][bj][m][n]; }
                asm volatile("" ::: "memory"); }
    }
};
struct EpiSwiGLU {
    static constexpr bool PERM = true;
    bf16_t* hid;
    __device__ __forceinline__ void operator()(AccRef acc, const pg8::Unit& u, int wr, int wc, int fr, int fq) const {
        bf16_t* tile = hid + (size_t)u.pm * 256 * 512 + u.pn * 128;
        int r0 = wr * 64 + fr, c0 = wc * 32 + 8 * fq; asm volatile("" : "+v"(r0), "+v"(c0));
#pragma unroll
        for (int ai = 0; ai < 2; ++ai)
#pragma unroll
            for (int m = 0; m < 4; ++m) { bf16_t* rowp = tile + (size_t)(r0 + ai * 128 + m * 16) * 512 + c0;
                float o[8];
#pragma unroll
                for (int n = 0; n < 2; ++n)
#pragma unroll
                    for (int j = 0; j < 4; ++j) { const float g = acc[ai][0][m][n][j], up = acc[ai][1][m][n][j]; o[n * 4 + j] = g * sigmoidf_(g) * up; }
                *(u32x4*)rowp = pack8(o); }
    }
};
struct EpiSilu {
    static constexpr bool PERM = true;
    bf16_t* out; int ldc;
    __device__ __forceinline__ void operator()(AccRef acc, const pg8::Unit& u, int wr, int wc, int fr, int fq) const {
        bf16_t* tile = out + (size_t)u.pm * 256 * ldc + u.pn * 256;
        int r0 = wr * 64 + fr, c0 = wc * 32 + 8 * fq; asm volatile("" : "+v"(r0), "+v"(c0));
#pragma unroll
        for (int ai = 0; ai < 2; ++ai)
#pragma unroll
            for (int m = 0; m < 4; ++m) { bf16_t* rowp = tile + (size_t)(r0 + ai * 128 + m * 16) * ldc + c0;
#pragma unroll
                for (int bj = 0; bj < 2; ++bj) { float o[8];
#pragma unroll
                    for (int n = 0; n < 2; ++n)
#pragma unroll
                        for (int j = 0; j < 4; ++j) { const float g = acc[ai][bj][m][n][j]; o[n * 4 + j] = g * sigmoidf_(g); }
                    *(u32x4*)(rowp + bj * 128) = pack8(o); } }
    }
};
struct EpiRotary {
    static constexpr bool PERM = true;
    bf16_t* out; int ldc; size_t pm_stride, pn_stride; const float* rot; int tok0; float scale;
    __device__ __forceinline__ void operator()(AccRef acc, const pg8::Unit& u, int wr, int wc, int fr, int fq) const {
        bf16_t* tile = out + (size_t)u.pm * pm_stride + (size_t)u.pn * pn_stride;
        int r0 = wr * 64 + fr, c0 = wc * 32 + 8 * fq; asm volatile("" : "+v"(r0), "+v"(c0));
#pragma unroll
        for (int ai = 0; ai < 2; ++ai)
#pragma unroll
            for (int m = 0; m < 4; ++m) { const int r = r0 + ai * 128 + m * 16; bf16_t* rowp = tile + (size_t)r * ldc + c0;
                const float* rt = rot + ((size_t)(tok0 + u.pm * 256 + r) * 128 + (c0 >> 1)) * 2;
#pragma unroll
                for (int bj = 0; bj < 2; ++bj) { const f32x4 cs0 = *(const f32x4*)(rt + bj * 128), cs1 = *(const f32x4*)(rt + bj * 128 + 4);
                    const f32x4 v0 = acc[ai][bj][m][0], v1 = acc[ai][bj][m][1]; float o[8];
                    o[0] = (v0[0] * cs0[0] - v0[1] * cs0[1]) * scale; o[1] = (v0[1] * cs0[0] + v0[0] * cs0[1]) * scale;
                    o[2] = (v0[2] * cs0[2] - v0[3] * cs0[3]) * scale; o[3] = (v0[3] * cs0[2] + v0[2] * cs0[3]) * scale;
                    o[4] = (v1[0] * cs1[0] - v1[1] * cs1[1]) * scale; o[5] = (v1[1] * cs1[0] + v1[0] * cs1[1]) * scale;
                    o[6] = (v1[2] * cs1[2] - v1[3] * cs1[3]) * scale; o[7] = (v1[3] * cs1[2] + v1[2] * cs1[3]) * scale;
                    *(u32x4*)(rowp + bj * 128) = pack8(o); } }
    }
};
struct EpiSprime {
    static constexpr bool PERM = true;
    bf16_t* qcat;
    __device__ __forceinline__ void operator()(AccRef acc, const pg8::Unit& u, int wr, int wc, int fr, int fq) const {
        bf16_t* tile = qcat + ((size_t)u.x0 * 16384 + (size_t)u.pm * 256) * 512;
        const float l2g = __log2f(1.0f - exp2f(-5.0f - (float)u.x0));
        int r0 = wr * 64 + fr, c0 = wc * 32 + 8 * fq; asm volatile("" : "+v"(r0), "+v"(c0));
#pragma unroll
        for (int bj = 0; bj < 2; ++bj) {
            float cf[8];
#pragma unroll
            for (int j = 0; j < 8; ++j) cf[j] = __builtin_amdgcn_exp2f(-(float)(c0 + bj * 128 + j + 1) * l2g);
#pragma unroll
            for (int ai = 0; ai < 2; ++ai)
#pragma unroll
                for (int m = 0; m < 4; ++m) { const int r = r0 + ai * 128 + m * 16; bf16_t* rowp = tile + (size_t)r * 512 + c0; float o[8];
#pragma unroll
                    for (int n = 0; n < 2; ++n)
#pragma unroll
                        for (int j = 0; j < 4; ++j) { const int c = c0 + bj * 128 + n * 4 + j; const unsigned keep = ~(unsigned)((r - c) >> 31);
                            o[n * 4 + j] = __builtin_bit_cast(float, __builtin_bit_cast(unsigned, acc[ai][bj][m][n][j] * cf[n * 4 + j]) & keep); }
                    *(u32x4*)(rowp + bj * 128) = pack8(o); }
        }
    }
};
struct EpiY {
    static constexpr bool PERM = true;
    bf16_t* yb; f32x2* stats;
    __device__ __forceinline__ void operator()(AccRef acc, const pg8::Unit& u, int wr, int wc, int fr, int fq) const {
        bf16_t* tile = yb + (size_t)u.pm * 256 * 4096 + u.x0 * 512 + u.pn * 256;
        const float l2g = __log2f(1.0f - exp2f(-5.0f - (float)u.x0));
        int r0 = wr * 64 + fr, c0 = wc * 32 + 8 * fq; asm volatile("" : "+v"(r0), "+v"(c0));
#pragma unroll
        for (int ai = 0; ai < 2; ++ai)
#pragma unroll
            for (int m = 0; m < 4; ++m) { const int r = r0 + ai * 128 + m * 16; bf16_t* rowp = tile + (size_t)r * 4096 + c0; const float rf = __builtin_amdgcn_exp2f((float)(r + 1) * l2g);
                float s1 = 0.f, s2 = 0.f;
#pragma unroll
                for (int bj = 0; bj < 2; ++bj) { const f32x4 v0 = acc[ai][bj][m][0] * rf, v1 = acc[ai][bj][m][1] * rf;
                    s1 += (v0[0] + v0[1]) + (v0[2] + v0[3]) + (v1[0] + v1[1]) + (v1[2] + v1[3]);
                    s2 += (v0[0] * v0[0] + v0[1] * v0[1]) + (v0[2] * v0[2] + v0[3] * v0[3]) + (v1[0] * v1[0] + v1[1] * v1[1]) + (v1[2] * v1[2] + v1[3] * v1[3]);
                    u32x4 w; w.x = pk2(v0[0], v0[1]); w.y = pk2(v0[2], v0[3]); w.z = pk2(v1[0], v1[1]); w.w = pk2(v1[2], v1[3]);
                    *(u32x4*)(rowp + bj * 128) = w; }
                s1 += __shfl_xor(s1, 16); s2 += __shfl_xor(s2, 16); s1 += __shfl_xor(s1, 32); s2 += __shfl_xor(s2, 32);
                if (fq == 0) { f32x2 st; st.x = s1; st.y = s2; stats[((size_t)(u.pm * 256 + r) * 8 + u.x0) * 8 + u.pn * 4 + wc] = st; } }
    }
};
struct EpiGnorm {
    static constexpr bool PERM = true;
    bf16_t* yb; const f32x2* stats; const float* gain;
    __device__ __forceinline__ void operator()(AccRef acc, const pg8::Unit& u, int wr, int wc, int fr, int fq) const {
        const int h = u.pn >> 1;
        bf16_t* tile = yb + (size_t)u.pm * 256 * 4096 + u.pn * 256;
        const float* gn = gain + u.pn * 256;
        int r0 = wr * 64 + fr, c0 = wc * 32 + 8 * fq; asm volatile("" : "+v"(r0), "+v"(c0));
#pragma unroll
        for (int ai = 0; ai < 2; ++ai)
#pragma unroll
            for (int m = 0; m < 4; ++m) { const int r = r0 + ai * 128 + m * 16; bf16_t* rowp = tile + (size_t)r * 4096 + c0;
                const f32x4* sp = (const f32x4*)(stats + ((size_t)(u.pm * 256 + r) * 8 + h) * 8);
                const f32x4 a0 = sp[0], a1 = sp[1], a2 = sp[2], a3 = sp[3];
                const float s1 = (a0.x + a0.z) + (a1.x + a1.z) + (a2.x + a2.z) + (a3.x + a3.z), s2 = (a0.y + a0.w) + (a1.y + a1.w) + (a2.y + a2.w) + (a3.y + a3.w);
                const float mu = s1 * (1.0f / 512.0f); const float rstd = __builtin_amdgcn_rsqf(fmaxf(s2 * (1.0f / 512.0f) - mu * mu, 0.f) + EPS);
#pragma unroll
                for (int bj = 0; bj < 2; ++bj) { float y[8]; unpack8(*(const u32x4*)(rowp + bj * 128), y);
                    const f32x4 g0 = *(const f32x4*)(gn + c0 + bj * 128), g1 = *(const f32x4*)(gn + c0 + bj * 128 + 4);
                    const float gg[8] = {g0.x, g0.y, g0.z, g0.w, g1.x, g1.y, g1.z, g1.w}; float o[8];
#pragma unroll
                    for (int n = 0; n < 2; ++n)
#pragma unroll
                        for (int j = 0; j < 4; ++j) { const float g = acc[ai][bj][m][n][j]; o[n * 4 + j] = g * sigmoidf_(g) * ((y[n * 4 + j] - mu) * rstd * gg[n * 4 + j]); }
                    *(u32x4*)(rowp + bj * 128) = pack8(o); } }
    }
};
struct EpiRotaryT {
    static constexpr bool PERM = true;
    bf16_t* out; bf16_t* kdt; const float* rot; int tok0; float scale;
    __device__ __forceinline__ void operator()(AccRef acc, const pg8::Unit& u, int wr, int wc, int fr, int fq) const {
        bf16_t* tile = out + (size_t)u.pm * 256 * 2048 + (size_t)u.pn * 256;
        bf16_t* ttile = kdt + (size_t)u.pn * 256 * 16384 + (size_t)u.pm * 256;
        const float l2g = __log2f(1.0f - exp2f(-5.0f - (float)u.pn));
        int r0 = wr * 64 + fr, c0 = wc * 32 + 8 * fq; asm volatile("" : "+v"(r0), "+v"(c0));
#pragma unroll
        for (int ai = 0; ai < 2; ++ai)
#pragma unroll
            for (int m = 0; m < 4; ++m) { const int r = r0 + ai * 128 + m * 16; bf16_t* rowp = tile + (size_t)r * 2048 + c0;
                const float* rt = rot + ((size_t)(tok0 + u.pm * 256 + r) * 128 + (c0 >> 1)) * 2;
                const float dk = __builtin_amdgcn_exp2f((float)(255 - r) * l2g);
#pragma unroll
                for (int bj = 0; bj < 2; ++bj) { const f32x4 cs0 = *(const f32x4*)(rt + bj * 128), cs1 = *(const f32x4*)(rt + bj * 128 + 4);
                    const f32x4 v0 = acc[ai][bj][m][0], v1 = acc[ai][bj][m][1]; float o[8];
                    o[0] = (v0[0] * cs0[0] - v0[1] * cs0[1]) * scale; o[1] = (v0[1] * cs0[0] + v0[0] * cs0[1]) * scale;
                    o[2] = (v0[2] * cs0[2] - v0[3] * cs0[3]) * scale; o[3] = (v0[3] * cs0[2] + v0[2] * cs0[3]) * scale;
                    o[4] = (v1[0] * cs1[0] - v1[1] * cs1[1]) * scale; o[5] = (v1[1] * cs1[0] + v1[0] * cs1[1]) * scale;
                    o[6] = (v1[2] * cs1[2] - v1[3] * cs1[3]) * scale; o[7] = (v1[3] * cs1[2] + v1[2] * cs1[3]) * scale;
                    *(u32x4*)(rowp + bj * 128) = pack8(o);
                    bf16_t* tp = ttile + (size_t)(c0 + bj * 128) * 16384 + r;
#pragma unroll
                    for (int j = 0; j < 8; ++j) tp[(size_t)j * 16384] = (bf16_t)f2bf(o[j] * dk); } }
    }
};

struct GateSched {
    static constexpr bool GATHER = false;
    const char* A; const char* B; int G, c; static constexpr int lda = 1024, ldb = 256, K = 256;
    __device__ __forceinline__ bool next(int i, pg8::Unit& u) const {
        const int L = i * G + c; if (L >= 128 * 8) return false;
        const int pm = L >> 3, j = (L >> 1) & 3, pn = L & 1;
        u.pm = pm; u.pn = j * 2 + pn; u.x0 = 0; u.x1 = 0; u.a = A + ((size_t)pm * 256 * 1024 + j * 256) * 2; u.b = B + ((size_t)(j * 512 + pn * 256) * 256) * 2; return true;
    }
    __device__ __forceinline__ unsigned row_off(const pg8::Unit&, int) const { return 0u; }
};
struct Moe1Sched {
    static constexpr bool GATHER = true;
    const char* A; const char* B; const int* rowtok; const LAS int* tt; int G, c; static constexpr int lda = 2048, ldb = 2048, K = 2048;
    __device__ __forceinline__ bool next(int i, pg8::Unit& u) const {
        const int L = i * G + c; if (L >= tt[0] * 4) return false;
        const int rt = L >> 2, pn = L & 3, e = tt[1 + rt];
        u.pm = rt; u.pn = pn; u.x0 = e; u.x1 = 0; u.a = A; u.b = B + ((size_t)(e * 1024 + pn * 256) * 2048) * 2; return true;
    }
    __device__ __forceinline__ unsigned row_off(const pg8::Unit& u, int r) const { return (unsigned)rowtok[u.pm * 256 + r] * (unsigned)(2048 * 2); }
};
struct Moe2Sched {
    static constexpr bool GATHER = false;
    const char* A; const char* B; const LAS int* tt; int G, c; static constexpr int lda = 512, ldb = 512, K = 512;
    __device__ __forceinline__ bool next(int i, pg8::Unit& u) const {
        const int L = i * G + c; if (L >= tt[0] * 8) return false;
        const int rt = L >> 3, pn = L & 7, e = tt[1 + rt];
        u.pm = rt; u.pn = pn; u.x0 = e; u.x1 = 0; u.a = A + (size_t)rt * 256 * 512 * 2; u.b = B + ((size_t)(e * 2048 + pn * 256) * 512) * 2; return true;
    }
    __device__ __forceinline__ unsigned row_off(const pg8::Unit&, int) const { return 0u; }
};
struct SpSched {
    static constexpr bool GATHER = false;
    const char* qcat; const char* kb; int G, c; static constexpr int lda = 512, ldb = 2048, K = 256;
    __device__ __forceinline__ bool next(int i, pg8::Unit& u) const {
        const int L = i * G + c; if (L >= 512) return false;
        const int h = L >> 6, n = L & 63;
        u.pm = n; u.pn = 0; u.x0 = h; u.x1 = 0; u.a = qcat + (((size_t)h * 16384 + (size_t)n * 256) * 512 + 256) * 2; u.b = kb + ((size_t)n * 256 * 2048 + h * 256) * 2; return true;
    }
    __device__ __forceinline__ unsigned row_off(const pg8::Unit&, int) const { return 0u; }
};
struct KvSched {
    static constexpr bool GATHER = false;
    const char* vr; const char* kdt; int G, c; static constexpr int lda = 512, ldb = 16384, K = 256;
    __device__ __forceinline__ bool next(int i, pg8::Unit& u) const {
        const int L = i * G + c; if (L >= 1024) return false;
        const int hn = L >> 1, pe = L & 1, h = hn >> 6, n = hn & 63;
        const size_t o = ((size_t)hn * 512 + pe * 256) * 512;
        u.pm = 0; u.pn = 0; u.x0 = (int)(unsigned)((o + 256) & 0xffffffffu); u.x1 = (int)(unsigned)((o + 256) >> 32);
        u.a = vr + o * 2; u.b = kdt + ((size_t)h * 256 * 16384 + (size_t)n * 256) * 2; return true;
    }
    __device__ __forceinline__ unsigned row_off(const pg8::Unit&, int) const { return 0u; }
};
struct YSched {
    static constexpr bool GATHER = false;
    const char* qcat; const char* vr; int G, c; static constexpr int lda = 512, ldb = 512, K = 512;
    __device__ __forceinline__ bool next(int i, pg8::Unit& u) const {
        const int L = i * G + c; if (L >= 1024) return false;
        const int hn = L >> 1, pn = L & 1, h = hn >> 6, n = hn & 63;
        u.pm = n; u.pn = pn; u.x0 = h; u.x1 = 0; u.a = qcat + (((size_t)h * 16384 + (size_t)n * 256) * 512) * 2; u.b = vr + (((size_t)hn * 512 + pn * 256) * 512) * 2; return true;
    }
    __device__ __forceinline__ unsigned row_off(const pg8::Unit&, int) const { return 0u; }
};
struct VtSched {
    static constexpr bool GATHER = false;
    const char* w; const char* hb; int G, c; static constexpr int lda = 2048, ldb = 2048, K = 2048;
    __device__ __forceinline__ bool next(int i, pg8::Unit& u) const {
        const int L = i * G + c; if (L >= 1024) return false;
        int pmE, n; pg8::tile_order(L, 16, 64, pmE, n);
        const int h = pmE >> 1;
        const size_t o = (((size_t)(h * 64 + n)) * 512 + (pmE & 1) * 256) * 512;
        u.pm = pmE; u.pn = n; u.x0 = (int)(unsigned)(o & 0xffffffffu); u.x1 = (int)(unsigned)(o >> 32);
        u.a = w + (size_t)pmE * 256 * 2048 * 2; u.b = hb + (size_t)n * 256 * 2048 * 2; return true;
    }
    __device__ __forceinline__ unsigned row_off(const pg8::Unit&, int) const { return 0u; }
};

struct Args { const void* in[25]; float* out; unsigned char* ws; int ph_lo, ph_hi; int li, pad; };

struct Frame {
    LAS unsigned char* lds; int tid, lane, wave, G, bid;
};

struct RmIdent { __device__ __forceinline__ int operator()(int n) const { return n; } };
struct RmOdIn { __device__ __forceinline__ int operator()(int n) const { if (n >= 4096) return n; const int r = n & 255; return (n & ~255) + (r < 128 ? 2 * r : 2 * (r - 128) + 1); } };
struct RmGU { int add; __device__ __forceinline__ int operator()(int n) const { return (n >> 7) * 256 + (n & 127) + add; } };
template <class RM>
__device__ __forceinline__ void transpose_item(const float* W, int K, int N, bf16_t* WT, const RM rm, LAS float* scr, int item, int lane) {
    const int nblk = N / 32, kb = item / nblk, nb = item % nblk, k0 = 64 * kb, n0 = 32 * nb;
#pragma unroll 8
    for (int i = 0; i < 32; ++i) { const int kk = 2 * i + (lane >> 5); scr[kk * 33 + (lane & 31)] = W[(size_t)(k0 + kk) * N + n0 + (lane & 31)]; }
    LDS_WAIT(); asm volatile("" ::: "memory");
    const int c = lane & 7;
#pragma unroll
    for (int j = 0; j < 4; ++j) { const int n = (lane >> 3) + 8 * j; const LAS float* s = scr + (8 * c) * 33 + n;
        u32x4 o; o.x = pk2(s[0 * 33], s[1 * 33]); o.y = pk2(s[2 * 33], s[3 * 33]); o.z = pk2(s[4 * 33], s[5 * 33]); o.w = pk2(s[6 * 33], s[7 * 33]);
        *(u32x4*)(WT + (size_t)rm(n0 + n) * K + k0 + 8 * c) = o; }
    LDS_WAIT(); asm volatile("" ::: "memory");
}
__device__ __forceinline__ void convert_experts(const Frame& F, const float* wg, const float* wu, const float* wd, unsigned char* ws) {
    LAS float* scr = (LAS float*)(F.lds + F.wave * 16384);
    const int gw = F.bid * 8 + F.wave, NGW = F.G * 8;
    bf16_t* gu = (bf16_t*)(ws + WS_WGU); bf16_t* dd = (bf16_t*)(ws + WS_WD);
    for (int it = gw; it < 3 * 16384; it += NGW) {
        const int which = it >> 14, r = it & 16383, e = r >> 9, ii = r & 511;
        if (which == 0) transpose_item(wg + (size_t)e * 2048 * 512, 2048, 512, gu + (size_t)e * 1024 * 2048, RmGU{0}, scr, ii, F.lane);
        else if (which == 1) transpose_item(wu + (size_t)e * 2048 * 512, 2048, 512, gu + (size_t)e * 1024 * 2048, RmGU{128}, scr, ii, F.lane);
        else transpose_item(wd + (size_t)e * 512 * 2048, 512, 2048, dd + (size_t)e * 2048 * 512, RmIdent{}, scr, ii, F.lane);
    }
}
__device__ __forceinline__ void rms_row_to_bf16(const float* xrow, const float* gain, bf16_t* orow, int lane) {
    const f32x4* xr = (const f32x4*)xrow + lane; const f32x4* gr = (const f32x4*)gain + lane;
    f32x4 v[8]; float s = 0.f;
#pragma unroll
    for (int j = 0; j < 8; ++j) { v[j] = xr[64 * j]; s += (v[j].x * v[j].x + v[j].y * v[j].y) + (v[j].z * v[j].z + v[j].w * v[j].w); }
    const float rstd = 1.0f / sqrtf(wave_sum(s) * (1.0f / D) + EPS);
    u32x2* o8 = (u32x2*)orow + lane;
#pragma unroll
    for (int j = 0; j < 8; ++j) { const f32x4 g = gr[64 * j]; u32x2 w; w.x = pk2(v[j].x * rstd * g.x, v[j].y * rstd * g.y); w.y = pk2(v[j].z * rstd * g.z, v[j].w * rstd * g.w); o8[64 * j] = w; }
}

typedef const __attribute__((address_space(4))) Args* ArgP;
__device__ __forceinline__ ArgP launder(ArgP p) { asm volatile("" : "+s"(p)); return p; }
#define INP(T_, k) ((const T_*)ap->in[k])
__device__ __forceinline__ Frame relaunder(const Frame& f) { Frame g = f; asm volatile("" : "+v"(g.tid)); g.lane = g.tid & 63; g.wave = __builtin_amdgcn_readfirstlane(g.tid >> 6); return g; }

__device__ __forceinline__ void ph_prologue(ArgP ap, const Frame& F_) {
    ap = launder(ap); unsigned char* ws = ap->ws; const Frame F = relaunder(F_);
    const int gw = F.bid * 8 + F.wave, NGW = F.G * 8, gt = F.bid * 512 + F.tid, NGT = F.G * 512;
    LAS float* scr = (LAS float*)(F.lds + F.wave * 16384);
    constexpr int I_A = 32 * 160, I_B = 32 * 64, I_C = 32 * 384, I_D = 64 * 64;
    for (int it = gw; it < I_A + I_B + I_C + I_D; it += NGW) {
        int r = it;
        if (r < I_A) { transpose_item(INP(float, 3), 2048, EV_IN, (bf16_t*)(ws + WS_WEVI), RmIdent{}, scr, r, F.lane); continue; } r -= I_A;
        if (r < I_B) { transpose_item(INP(float, 11), 2048, 2048, (bf16_t*)(ws + WS_WEVO), RmIdent{}, scr, r, F.lane); continue; } r -= I_B;
        if (r < I_C) { transpose_item(INP(float, 13), 2048, OD_IN, (bf16_t*)(ws + WS_WOD), RmOdIn{}, scr, r, F.lane); continue; } r -= I_C;
        transpose_item(INP(float, 15), 4096, 2048, (bf16_t*)(ws + WS_WODO), RmIdent{}, scr, r, F.lane);
    }
    convert_experts(F, INP(float, 21), INP(float, 22), INP(float, 23), ws);
    { bf16_t* wgp = (bf16_t*)(ws + WS_WGATE); const float* ga = INP(float, 6); const float* gx = INP(float, 8);
      for (int idx = gt; idx < 4 * 512 * 256; idx += NGT) { const int j = idx >> 17, o = (idx >> 8) & 511, kk = idx & 255, pn = o >> 8, bx = (o >> 7) & 1, ch = o & 127, g = 2 * j + pn, gk = 2 * j + (kk >> 7), i = kk & 127;
          const float v = (gk == g) ? (bx ? gx : ga)[(g * 128 + i) * 128 + ch] : 0.f; wgp[idx] = (bf16_t)f2bf(v); } }
    { float* rot = (float*)(ws + WS_ROT); const int* positions = INP(int, 1);
      for (int idx = gt; idx < T * 128; idx += NGT) { const int t = idx >> 7, i = idx & 127;
          const float inv = exp2f(-(float)i * (13.287712379549449f / 128.0f)); const float ang = (float)positions[t] * inv;
          const float k = rintf(ang * 0.15915494309189535f); float r = fmaf(-k, 6.28125f, ang); r = fmaf(-k, 1.9353071795864769e-3f, r);
          f32x2 cs; cs.x = __cosf(r); cs.y = __sinf(r); *(f32x2*)(rot + (size_t)idx * 2) = cs; } }
    { const float* x_in = INP(float, 0); const float* g = INP(float, 2); bf16_t* Hb = (bf16_t*)(ws + WS_H);
      for (int m = gw; m < T; m += NGW) rms_row_to_bf16(x_in + (size_t)m * D, g, Hb + (size_t)m * D, F.lane); }
}
__device__ __forceinline__ void ph_inproj0(ArgP ap, const Frame& F_) {
    ap = launder(ap); unsigned char* ws = ap->ws; const Frame F = relaunder(F_);
    pg8::DenseSched<128, 20, 2048, 2048, 2048> S{(const char*)(ws + WS_H), (const char*)(ws + WS_WEVI), F.G, F.bid};
    EpiPlain E{(bf16_t*)(ws + WS_PROJ0), EV_IN, (size_t)256 * EV_IN, 256};
    pg8::gemm_phase(F.lds, S, E);
}
__device__ __forceinline__ void ph_conv_attn(ArgP ap, const Frame& F_) {
    ap = launder(ap); unsigned char* ws = ap->ws; const Frame F = relaunder(F_);
    const int gt = F.bid * 512 + F.tid, NGT = F.G * 512;
    const bf16_t* proj = (const bf16_t*)(ws + WS_PROJ0);
    { bf16_t* xc = (bf16_t*)(ws + WS_XC); const float* cw = INP(float, 4); const float* cb = INP(float, 5);
      const int c8 = (gt & 127) * 8; float wk[4][8], bb[8];
#pragma unroll
      for (int j = 0; j < 8; ++j) { bb[j] = cb[c8 + j];
#pragma unroll
          for (int k = 0; k < 4; ++k) wk[k][j] = cw[k * 1024 + c8 + j]; }
      for (int t = gt >> 7; t < T; t += NGT >> 7) { const int s = t & (SEQ - 1);
          float a[8];
#pragma unroll
          for (int j = 0; j < 8; ++j) a[j] = bb[j];
#pragma unroll
          for (int k = 0; k < 4; ++k) { if (s - 3 + k >= 0) { const u32x4 w = *(const u32x4*)(proj + (size_t)(t - 3 + k) * EV_IN + c8); float f[8]; unpack8(w, f);
#pragma unroll
                  for (int j = 0; j < 8; ++j) a[j] = fmaf(wk[k][j], f[j], a[j]); } }
          *(u32x4*)(xc + (size_t)t * 1024 + c8) = pack8(a); } }
    LAS unsigned char* L = F.lds;
    LAS bf16_t* Qs = (LAS bf16_t*)(L);
    LAS float* Zs = (LAS float*)(L);
    LAS bf16_t* Ks = (LAS bf16_t*)(L + 34816);
    LAS bf16_t* VTs = (LAS bf16_t*)(L + 52224);
    LAS bf16_t* Ps = (LAS bf16_t*)(L + 70656);
    LAS bf16_t* Os = (LAS bf16_t*)(L);
    volatile LAS unsigned* alive = (volatile LAS unsigned*)(L + 89088);
    bf16_t* y0 = (bf16_t*)(ws + WS_Y0);
    const int w = F.wave, l = F.lane, l15 = l & 15, l4 = l >> 4;
    const float scale = 0.08838834764831845f;
    for (int u = F.bid; u < 2048; u += F.G) {
        const int b = u >> 10, h = (u >> 7) & 7, qt = u & 127; const int t0 = b * SEQ + qt * 128;
        __syncthreads();
        for (int i = 0; i < 4; ++i) { const int id = F.tid + 512 * i, row = id >> 4, ch = id & 15;
            *(LAS u32x4*)(Qs + row * 136 + ch * 8) = *(const u32x4*)(proj + (size_t)(t0 + row) * EV_IN + 2048 + h * 128 + ch * 8); }
        __syncthreads();
        bf16x8 qf[4];
#pragma unroll
        for (int ks = 0; ks < 4; ++ks) qf[ks] = *(const LAS bf16x8*)(Qs + (16 * w + l15) * 136 + 32 * ks + 8 * l4);
        f32x4 o[8];
#pragma unroll
        for (int dt = 0; dt < 8; ++dt) o[dt] = (f32x4){0.f, 0.f, 0.f, 0.f};
        float carry = 0.f;
        const int srow = F.tid >> 2, sp = F.tid & 3;
        u32x4 kr[2], vr[2];
#define ATT_LOADKV(kb_) do { const int k0_ = b * SEQ + (kb_) * 64; _Pragma("unroll") for (int i = 0; i < 2; ++i) { const int id = F.tid + 512 * i; \
            kr[i] = *(const u32x4*)(proj + (size_t)(k0_ + (id >> 4)) * EV_IN + 3072 + h * 128 + (id & 15) * 8); \
            vr[i] = *(const u32x4*)(proj + (size_t)(k0_ + (id & 63)) * EV_IN + 4096 + h * 128 + (id >> 6) * 8); } } while (0)
        ATT_LOADKV(2 * qt + 1);
        for (int kb = 2 * qt + 1; kb >= 0; --kb) {
            __syncthreads();
#pragma unroll
            for (int i = 0; i < 2; ++i) { const int id = F.tid + 512 * i, row = id >> 4, ch = id & 15;
                *(LAS u32x4*)(Ks + row * 136 + ch * 8) = kr[i]; }
#pragma unroll
            for (int i = 0; i < 2; ++i) { const int id = F.tid + 512 * i, key = id & 63, ch = id >> 6;
                const unsigned ww[4] = {vr[i].x, vr[i].y, vr[i].z, vr[i].w};
#pragma unroll
                for (int j = 0; j < 4; ++j) { VTs[(8 * ch + 2 * j) * 72 + key] = (bf16_t)(ww[j] & 0xffffu); VTs[(8 * ch + 2 * j + 1) * 72 + key] = (bf16_t)(ww[j] >> 16); } }
            if (F.tid == 0) alive[0] = 0u;
            __syncthreads();
            if (kb > 0) ATT_LOADKV(kb - 1);
            f32x4 sacc[4];
#pragma unroll
            for (int kt = 0; kt < 4; ++kt) { sacc[kt] = (f32x4){0.f, 0.f, 0.f, 0.f};
#pragma unroll
                for (int ks = 0; ks < 4; ++ks) { const bf16x8 kf = *(const LAS bf16x8*)(Ks + (16 * kt + l15) * 136 + 32 * ks + 8 * l4);
                    sacc[kt] = __builtin_amdgcn_mfma_f32_16x16x32_bf16(qf[ks], kf, sacc[kt], 0, 0, 0); } }
#pragma unroll
            for (int kt = 0; kt < 4; ++kt)
#pragma unroll
                for (int rg = 0; rg < 4; ++rg) Zs[(16 * w + 4 * l4 + rg) * 68 + 16 * kt + l15] = sacc[kt][rg] * scale;
            __syncthreads();
            { float z[16], m1[16];
#pragma unroll
              for (int j4 = 0; j4 < 4; ++j4) { const f32x4 zz = *(const LAS f32x4*)(Zs + srow * 68 + 16 * sp + 4 * j4); z[4 * j4] = zz.x; z[4 * j4 + 1] = zz.y; z[4 * j4 + 2] = zz.z; z[4 * j4 + 3] = zz.w; }
              const int qs = qt * 128 + srow;
              float tot = 0.f;
#pragma unroll
              for (int j = 0; j < 16; ++j) { const int ksq = kb * 64 + 16 * sp + j; const bool ok = ksq < qs;
                  const float sp_ = fmaxf(z[j], 0.f) + __logf(1.0f + __expf(-fabsf(z[j])));
                  m1[j] = ok ? -sp_ : 0.f; tot += m1[j]; }
              const float t1 = __shfl_down(tot, 1), t2 = __shfl_down(tot, 2), t3 = __shfl_down(tot, 3);
              const float hi_sum = (sp < 3 ? t1 : 0.f) + (sp < 2 ? t2 : 0.f) + (sp < 1 ? t3 : 0.f);
              float run = carry + hi_sum;
              const float rowtot = __shfl(tot + hi_sum, (l & ~3));
              float pw[16];
#pragma unroll
              for (int j = 15; j >= 0; --j) { const int ksq = kb * 64 + 16 * sp + j; const bool ok = ksq < qs;
                  pw[j] = ok ? __expf(m1[j] + z[j] + run) : 0.f; run += m1[j]; }
              carry += rowtot;
              u32x4 w0, w1; w0.x = pk2(pw[0], pw[1]); w0.y = pk2(pw[2], pw[3]); w0.z = pk2(pw[4], pw[5]); w0.w = pk2(pw[6], pw[7]);
              w1.x = pk2(pw[8], pw[9]); w1.y = pk2(pw[10], pw[11]); w1.z = pk2(pw[12], pw[13]); w1.w = pk2(pw[14], pw[15]);
              *(LAS u32x4*)(Ps + srow * 72 + 16 * sp) = w0; *(LAS u32x4*)(Ps + srow * 72 + 16 * sp + 8) = w1;
              if (carry > -104.0f) alive[0] = 1u; }
            __syncthreads();
#pragma unroll
            for (int ks = 0; ks < 2; ++ks) { const bf16x8 pf = *(const LAS bf16x8*)(Ps + (16 * w + l15) * 72 + 32 * ks + 8 * l4);
#pragma unroll
                for (int dt = 0; dt < 8; ++dt) { const bf16x8 vf = *(const LAS bf16x8*)(VTs + (16 * dt + l15) * 72 + 32 * ks + 8 * l4);
                    o[dt] = __builtin_amdgcn_mfma_f32_16x16x32_bf16(pf, vf, o[dt], 0, 0, 0); } }
            if (alive[0] == 0u) break;
        }
#undef ATT_LOADKV
        __syncthreads();
#pragma unroll
        for (int dt = 0; dt < 8; ++dt)
#pragma unroll
            for (int rg = 0; rg < 4; ++rg) Os[(16 * w + 4 * l4 + rg) * 136 + 16 * dt + l15] = (bf16_t)f2bf(o[dt][rg]);
        __syncthreads();
        for (int i = 0; i < 4; ++i) { const int id = F.tid + 512 * i, row = id >> 4, ch = id & 15;
            *(u32x4*)(y0 + (size_t)(t0 + row) * 2048 + 1024 + h * 128 + ch * 8) = *(const LAS u32x4*)(Os + row * 136 + ch * 8); }
    }
    __syncthreads();
}
__device__ __forceinline__ void ph_gates(ArgP ap, const Frame& F_) {
    ap = launder(ap); unsigned char* ws = ap->ws; const Frame F = relaunder(F_);
    GateSched S{(const char*)(ws + WS_XC), (const char*)(ws + WS_WGATE), F.G, F.bid};
    EpiPlain E{(bf16_t*)(ws + WS_GPRE), 2048, (size_t)256 * 2048, 256};
    pg8::gemm_phase(F.lds, S, E);
}
__device__ __forceinline__ void ph_scan(ArgP ap, const Frame& F_, const int pass) {
    ap = launder(ap); unsigned char* ws = ap->ws; const Frame F = relaunder(F_);
    const bf16_t* gpre = (const bf16_t*)(ws + WS_GPRE); const bf16_t* xc = (const bf16_t*)(ws + WS_XC); const bf16_t* proj = (const bf16_t*)(ws + WS_PROJ0);
    f32x2* SUB = (f32x2*)(ws + WS_SUB); f32x2* CH = (f32x2*)(ws + WS_CH); bf16_t* y0 = (bf16_t*)(ws + WS_Y0);
    LAS f32x2* Ls = (LAS f32x2*)F.lds;
    const int cg = F.tid & 127, sub = F.tid >> 7, ch0 = cg * 8, g = ch0 >> 7, chin = ch0 & 127;
    float ba[8], bx[8], spl[8];
    { const float* gab = INP(float, 7); const float* gxb = INP(float, 9); const float* lamp = INP(float, 10);
#pragma unroll
      for (int j = 0; j < 8; ++j) { ba[j] = gab[ch0 + j]; bx[j] = gxb[ch0 + j]; const float lam = lamp[ch0 + j]; spl[j] = fmaxf(-lam, 0.f) + log1pf(__expf(-fabsf(lam))); } }
    for (int u = F.bid; u < 256; u += F.G) {
        const int b = u >> 7, c = u & 127;
        float hst[8], Ast[8];
#pragma unroll
        for (int j = 0; j < 8; ++j) { hst[j] = 0.f; Ast[j] = 1.f; }
        __syncthreads();
        if (pass == 1) {
            { const int c2 = F.tid * 2; float h0 = 0.f, h1 = 0.f;
              for (int cc = 0; cc < c; ++cc) { const f32x4 s = *(const f32x4*)(CH + ((size_t)(b * 128 + cc) * 1024 + c2)); h0 = fmaf(s.x, h0, s.y); h1 = fmaf(s.z, h1, s.w); }
              ((LAS float*)Ls)[c2] = h0; ((LAS float*)Ls)[c2 + 1] = h1; }
            __syncthreads();
#pragma unroll
            for (int j = 0; j < 8; ++j) hst[j] = ((LAS float*)Ls)[ch0 + j];
            for (int s2 = 0; s2 < sub; ++s2) { const f32x2* sp2 = SUB + ((size_t)(b * 512 + c * 4 + s2) * 1024 + ch0);
#pragma unroll
                for (int j = 0; j < 8; ++j) { const f32x2 s = sp2[j]; hst[j] = fmaf(s.x, hst[j], s.y); } }
        }
        const int tbase = b * SEQ + c * 128 + sub * 32;
        for (int i = 0; i < 32; ++i) {
            const size_t t = (size_t)(tbase + i);
            float pa[8], px[8], xv[8];
            unpack8(*(const u32x4*)(gpre + t * 2048 + g * 256 + chin), pa);
            unpack8(*(const u32x4*)(gpre + t * 2048 + g * 256 + 128 + chin), px);
            unpack8(*(const u32x4*)(xc + t * 1024 + ch0), xv);
            float gr[8];
            if (pass == 1) unpack8(*(const u32x4*)(proj + t * EV_IN + 1024 + ch0), gr);
            float outv[8];
#pragma unroll
            for (int j = 0; j < 8; ++j) {
                const float r = sigmoidf_(pa[j] + ba[j]), ig = sigmoidf_(px[j] + bx[j]);
                const float la = -8.0f * r * spl[j]; const float a = __expf(la);
                const float mlt = __builtin_amdgcn_sqrtf(fmaxf(1.0f - a * a, 0.f));
                const float uu = mlt * (ig * xv[j]);
                hst[j] = fmaf(a, hst[j], uu); Ast[j] *= a;
                if (pass == 1) outv[j] = hst[j] * gelu_tanh(gr[j]);
            }
            if (pass == 1) *(u32x4*)(y0 + t * 2048 + ch0) = pack8(outv);
        }
        if (pass == 0) {
            f32x2* sp2 = SUB + ((size_t)(b * 512 + c * 4 + sub) * 1024 + ch0);
#pragma unroll
            for (int j = 0; j < 8; ++j) { f32x2 s; s.x = Ast[j]; s.y = hst[j]; sp2[j] = s; Ls[sub * 1024 + ch0 + j] = s; }
            __syncthreads();
            if (sub == 0) {
#pragma unroll
                for (int j = 0; j < 8; ++j) { float A = 1.f, Hh = 0.f;
#pragma unroll
                    for (int s2 = 0; s2 < 4; ++s2) { const f32x2 s = Ls[s2 * 1024 + ch0 + j]; Hh = fmaf(s.x, Hh, s.y); A *= s.x; }
                    f32x2 o; o.x = A; o.y = Hh; CH[(size_t)(b * 128 + c) * 1024 + ch0 + j] = o; }
            }
        }
    }
    __syncthreads();
}
__device__ __forceinline__ void ph_outproj0(ArgP ap, const Frame& F_) {
    ap = launder(ap); unsigned char* ws = ap->ws; const Frame F = relaunder(F_);
    pg8::DenseSched<128, 8, 2048, 2048, 2048> S{(const char*)(ws + WS_Y0), (const char*)(ws + WS_WEVO), F.G, F.bid};
    EpiResid E{INP(float, 0), ap->out, 0};
    pg8::gemm_phase(F.lds, S, E);
}
__device__ __forceinline__ void ph_l1_inproj(ArgP ap, const Frame& F_, const int b) {
    ap = launder(ap); unsigned char* ws = ap->ws; const Frame F = relaunder(F_);
    const char* Hbb = (const char*)(ws + WS_H) + (size_t)b * SEQ * D * 2; const char* wod = (const char*)(ws + WS_WOD); const float* rot = (const float*)(ws + WS_ROT);
    { pg8::DenseSched<64, 8, 2048, 2048, 2048> S{Hbb, wod, F.G, F.bid};
      EpiRotary E{(bf16_t*)(ws + WS_QCAT) + 256, 512, (size_t)256 * 512, (size_t)16384 * 512, rot, b * SEQ, 1.0f};
      pg8::gemm_phase(F.lds, S, E); }
    { pg8::DenseSched<64, 8, 2048, 2048, 2048> S{Hbb, wod + (size_t)2048 * 2048 * 2, F.G, F.bid};
      EpiRotaryT E{(bf16_t*)(ws + WS_KB), (bf16_t*)(ws + WS_KDT), rot, b * SEQ, 0.0625f};
      pg8::gemm_phase(F.lds, S, E); }
    { VtSched S{wod + (size_t)4096 * 2048 * 2, Hbb, F.G, F.bid};
      EpiUnitPtr E{(bf16_t*)(ws + WS_VRCAT), 512};
      pg8::gemm_phase(F.lds, S, E); }
}
__device__ __forceinline__ void ph_l1_kv(ArgP ap, const Frame& F_) {
    ap = launder(ap); unsigned char* ws = ap->ws; const Frame F = relaunder(F_);
    KvSched S{(const char*)(ws + WS_VRCAT), (const char*)(ws + WS_KDT), F.G, F.bid};
    EpiUnitPtr E{(bf16_t*)(ws + WS_VRCAT), 512};
    pg8::gemm_phase(F.lds, S, E);
}
__device__ __forceinline__ void ph_l1_rscan(ArgP ap, const Frame& F_) {
    ap = launder(ap); unsigned char* ws = ap->ws; const Frame F = relaunder(F_);
    bf16_t* vrcat = (bf16_t*)(ws + WS_VRCAT);
    for (int v = F.bid * 512 + F.tid; v < 131072; v += F.G * 512) {
        const int h = v >> 14, rem = v & 16383, e = rem >> 5, d8 = rem & 31;
        const float cd = __builtin_amdgcn_exp2f(256.0f * __log2f(1.0f - exp2f(-5.0f - (float)h)));
        bf16_t* p = vrcat + ((size_t)h * 64 * 512 + e) * 512 + 256 + d8 * 8;
        float R[8];
#pragma unroll
        for (int j = 0; j < 8; ++j) R[j] = 0.f;
        for (int n0 = 0; n0 < 64; n0 += 8) {
            u32x4 raw[8];
#pragma unroll
            for (int j2 = 0; j2 < 8; ++j2) raw[j2] = *(const u32x4*)(p + (size_t)(n0 + j2) * 512 * 512);
#pragma unroll
            for (int j2 = 0; j2 < 8; ++j2) { float kv[8]; unpack8(raw[j2], kv);
                *(u32x4*)(p + (size_t)(n0 + j2) * 512 * 512) = pack8(R);
#pragma unroll
                for (int j = 0; j < 8; ++j) R[j] = fmaf(cd, R[j], kv[j]); }
        }
    }
    { bf16_t* qcat = (bf16_t*)(ws + WS_QCAT);
      SpSched S{(const char*)qcat, (const char*)(ws + WS_KB), F.G, F.bid};
      EpiSprime E{qcat};
      pg8::gemm_phase(F.lds, S, E); }
}
__device__ __forceinline__ void ph_l1_y(ArgP ap, const Frame& F_) {
    ap = launder(ap); unsigned char* ws = ap->ws; const Frame F = relaunder(F_);
    YSched S{(const char*)(ws + WS_QCAT), (const char*)(ws + WS_VRCAT), F.G, F.bid};
    EpiY E{(bf16_t*)(ws + WS_YB), (f32x2*)(ws + WS_STATS)};
    pg8::gemm_phase(F.lds, S, E);
}
__device__ __forceinline__ void ph_l1_gnorm(ArgP ap, const Frame& F_, const int b) {
    ap = launder(ap); unsigned char* ws = ap->ws; const Frame F = relaunder(F_);
    const char* Hbb = (const char*)(ws + WS_H) + (size_t)b * SEQ * D * 2; const char* wod = (const char*)(ws + WS_WOD);
    pg8::DenseSched<64, 16, 2048, 2048, 2048> S{Hbb, wod + (size_t)8192 * 2048 * 2, F.G, F.bid};
    EpiGnorm E{(bf16_t*)(ws + WS_YB), (const f32x2*)(ws + WS_STATS), INP(float, 14)};
    pg8::gemm_phase(F.lds, S, E);
}
__device__ __forceinline__ void ph_l1_out(ArgP ap, const Frame& F_, const int b) {
    ap = launder(ap); unsigned char* ws = ap->ws; const Frame F = relaunder(F_);
    pg8::DenseSched<64, 8, 4096, 4096, 4096> S{(const char*)(ws + WS_YB), (const char*)(ws + WS_WODO), F.G, F.bid};
    EpiResid E{ap->out, ap->out, b * SEQ};
    pg8::gemm_phase(F.lds, S, E);
}
typedef float f32x16 __attribute__((ext_vector_type(16)));
__device__ __forceinline__ void ph_router(ArgP ap, const Frame& F_, const int layer) {
    ap = launder(ap); unsigned char* ws = ap->ws; const Frame F = relaunder(F_);
    if (layer == 1) convert_experts(F, INP(float, 21) + (size_t)32 * 2048 * 512, INP(float, 22) + (size_t)32 * 2048 * 512, INP(float, 23) + (size_t)32 * 512 * 2048, ws);
    const float* xres = ap->out; bf16_t* Hb = (bf16_t*)(ws + WS_H);
    int* CNT = (int*)(ws + SM_CNT); int* ASGE = (int*)(ws + SM_ASGE); int* ASGR = (int*)(ws + SM_ASGR); float* ASGW = (float*)(ws + SM_ASGW);
    const float* gain = INP(float, 16) + layer * D; const float* wgp = INP(float, 17) + (size_t)layer * D * 4; const float* wep = INP(float, 19) + (size_t)layer * D * 32;
    const float* bgp = INP(float, 18) + layer * 4; const float* bep = INP(float, 20) + layer * 32;
    LAS float* xs = (LAS float*)F.lds;
    LAS float* wc = xs + 128 * 65;
    LAS float* pe = wc + 64 * 40;
    LAS float* pg = pe + 2 * 128 * 33;
    LAS float* lg = pg + 4 * 128 * 5;
    LAS float* rs = lg + 128 * 36;
    LAS int* el = (LAS int*)(rs + 128);
    LAS int* wcnt = el + 256;
    const int w = F.wave, l = F.lane, mt = w & 3, kh = w >> 2, l31 = l & 31, l5 = l >> 5;
    const int tl = F.tid & 127, kq = F.tid >> 7;
    for (int tile = F.bid; tile < 256; tile += F.G) {
        const int tok0 = tile * 128;
        f32x16 acc;
#pragma unroll
        for (int i2 = 0; i2 < 16; ++i2) acc[i2] = 0.f;
        float g4[4] = {0.f, 0.f, 0.f, 0.f}; float ss = 0.f;
        f32x4 xr[4];
        const int srow = F.tid >> 4, sc4 = (F.tid & 15) * 4;
#pragma unroll
        for (int i2 = 0; i2 < 4; ++i2) xr[i2] = *(const f32x4*)(xres + (size_t)(tok0 + srow + 32 * i2) * D + sc4);
        float wpre[5];
#pragma unroll
        for (int i2 = 0; i2 < 5; ++i2) { const int idx = F.tid + 512 * i2; wpre[i2] = 0.f; if (idx < 64 * 36) { const int k = idx / 36, o = idx % 36;
            wpre[i2] = gain[k] * (o < 4 ? wgp[k * 4 + o] : wep[k * 32 + (o - 4)]); } }
        for (int kc = 0; kc < 32; ++kc) {
            __syncthreads();
#pragma unroll
            for (int i2 = 0; i2 < 4; ++i2) { LAS float* d = xs + (srow + 32 * i2) * 65 + sc4; d[0] = xr[i2].x; d[1] = xr[i2].y; d[2] = xr[i2].z; d[3] = xr[i2].w; }
#pragma unroll
            for (int i2 = 0; i2 < 5; ++i2) { const int idx = F.tid + 512 * i2; if (idx < 64 * 36) wc[(idx / 36) * 40 + (idx % 36)] = wpre[i2]; }
            __syncthreads();
            if (kc + 1 < 32) {
#pragma unroll
                for (int i2 = 0; i2 < 4; ++i2) xr[i2] = *(const f32x4*)(xres + (size_t)(tok0 + srow + 32 * i2) * D + (kc + 1) * 64 + sc4);
#pragma unroll
                for (int i2 = 0; i2 < 5; ++i2) { const int idx = F.tid + 512 * i2; if (idx < 64 * 36) { const int k = idx / 36, o = idx % 36, kk = (kc + 1) * 64 + k;
                    wpre[i2] = gain[kk] * (o < 4 ? wgp[kk * 4 + o] : wep[kk * 32 + (o - 4)]); } } }
#pragma unroll
            for (int s2 = 0; s2 < 16; ++s2) { const int k = 32 * kh + 2 * s2 + l5;
                acc = __builtin_amdgcn_mfma_f32_32x32x2f32(xs[(32 * mt + l31) * 65 + k], wc[k * 40 + 4 + l31], acc, 0, 0, 0); }
#pragma unroll
            for (int k2 = 0; k2 < 16; ++k2) { const int k = 16 * kq + k2; const float xv = xs[tl * 65 + k]; const f32x4 wv = *(const LAS f32x4*)(wc + k * 40);
                ss = fmaf(xv, xv, ss); g4[0] = fmaf(xv, wv.x, g4[0]); g4[1] = fmaf(xv, wv.y, g4[1]); g4[2] = fmaf(xv, wv.z, g4[2]); g4[3] = fmaf(xv, wv.w, g4[3]); }
        }
#pragma unroll
        for (int rg = 0; rg < 16; ++rg) pe[(kh * 128 + 32 * mt + (rg & 3) + 8 * (rg >> 2) + 4 * l5) * 33 + l31] = acc[rg];
        { LAS float* p = pg + (kq * 128 + tl) * 5; p[0] = g4[0]; p[1] = g4[1]; p[2] = g4[2]; p[3] = g4[3]; p[4] = ss; }
        __syncthreads();
        if (F.tid < 128) { float sq = 0.f;
#pragma unroll
            for (int q = 0; q < 4; ++q) sq += pg[(q * 128 + F.tid) * 5 + 4];
            rs[F.tid] = 1.0f / sqrtf(sq * (1.0f / D) + EPS); }
        __syncthreads();
        for (int idx = F.tid; idx < 128 * 36; idx += 512) { const int t = idx / 36, o = idx % 36; float v;
            if (o < 4) v = (pg[(0 * 128 + t) * 5 + o] + pg[(1 * 128 + t) * 5 + o]) + (pg[(2 * 128 + t) * 5 + o] + pg[(3 * 128 + t) * 5 + o]);
            else v = pe[t * 33 + (o - 4)] + pe[(128 + t) * 33 + (o - 4)];
            lg[idx] = v * rs[t] + (o < 4 ? bgp[o] : bep[o - 4]); }
        __syncthreads();
        if (F.tid < 128) {
            const LAS float* q = lg + F.tid * 36;
            int gi = 0; float gm = q[0];
#pragma unroll
            for (int j2 = 1; j2 < 4; ++j2) if (q[j2] > gm) { gm = q[j2]; gi = j2; }
            float gs = 0.f;
#pragma unroll
            for (int j2 = 0; j2 < 4; ++j2) gs += __expf(q[j2] - gm);
            const float gwt = 1.0f / gs;
            const LAS float* eq = q + 4 + gi * 8;
            int j0 = 0; float m0 = eq[0];
#pragma unroll
            for (int j2 = 1; j2 < 8; ++j2) if (eq[j2] > m0) { m0 = eq[j2]; j0 = j2; }
            int j1 = -1; float m1v = -3.0e38f;
#pragma unroll
            for (int j2 = 0; j2 < 8; ++j2) if (j2 != j0 && eq[j2] > m1v) { m1v = eq[j2]; j1 = j2; }
            const float p1 = __expf(m1v - m0);
            const float w0 = gwt / (1.0f + p1), w1 = gwt * p1 / (1.0f + p1);
            const int tok = tok0 + F.tid;
            el[2 * F.tid] = gi * 8 + j0; el[2 * F.tid + 1] = gi * 8 + j1;
            ASGE[2 * tok] = gi * 8 + j0; ASGE[2 * tok + 1] = gi * 8 + j1; ASGW[2 * tok] = w0; ASGW[2 * tok + 1] = w1;
        }
        __syncthreads();
        int myrank = 0, mye = 0;
        if (F.tid < 256) { mye = el[F.tid];
            for (int e = 0; e < 32; ++e) { const unsigned long long m = __ballot(mye == e); if (mye == e) myrank = __popcll(m & ((1ull << l) - 1ull)); if (l == 0) wcnt[w * 32 + e] = __popcll(m); } }
        __syncthreads();
        if (F.tid < 256) { int off = 0; for (int w2 = 0; w2 < w; ++w2) off += wcnt[w2 * 32 + mye]; ASGR[2 * tok0 + F.tid] = off + myrank; }
        if (F.tid < 32) CNT[tile * 32 + F.tid] = wcnt[F.tid] + wcnt[32 + F.tid] + wcnt[64 + F.tid] + wcnt[96 + F.tid];
        for (int r = w; r < 128; r += 8) { const float rsd = rs[r]; const f32x4* xrp = (const f32x4*)(xres + (size_t)(tok0 + r) * D) + l; const f32x4* grp = (const f32x4*)gain + l;
            u32x2* o8 = (u32x2*)(Hb + (size_t)(tok0 + r) * D) + l;
#pragma unroll
            for (int j2 = 0; j2 < 8; ++j2) { const f32x4 v = xrp[64 * j2], g = grp[64 * j2]; u32x2 ww; ww.x = pk2(v.x * rsd * g.x, v.y * rsd * g.y); ww.y = pk2(v.z * rsd * g.z, v.w * rsd * g.w); o8[64 * j2] = ww; } }
    }
    __syncthreads();
}
__device__ __forceinline__ void ph_dispatch(ArgP ap, const Frame& F_) {
    ap = launder(ap); unsigned char* ws = ap->ws; const Frame F = relaunder(F_);
    int* CNT = (int*)(ws + SM_CNT); int* TT = (int*)(ws + SM_TT); int* ASGE = (int*)(ws + SM_ASGE); int* ASGR = (int*)(ws + SM_ASGR); int* DEST = (int*)(ws + SM_DEST); int* ROWTOK = (int*)(ws + SM_ROWTOK);
    LAS int* cl = (LAS int*)F.lds;
    LAS int* tot = cl + 256 * 32;
    LAS int* tstart = tot + 32;
    LAS int* base = tstart + 32;
    __syncthreads();
    for (int idx = F.tid; idx < 256 * 32; idx += 512) cl[idx] = CNT[idx];
    __syncthreads();
    if (F.tid < 32) { int s = 0; for (int w2 = 0; w2 < 256; ++w2) s += cl[w2 * 32 + F.tid]; tot[F.tid] = s; }
    __syncthreads();
    if (F.tid == 0) { int acc2 = 0; for (int e = 0; e < 32; ++e) { tstart[e] = acc2; acc2 += (tot[e] + 255) >> 8; }
        if (F.bid == 0) { TT[0] = acc2; for (int e = 0; e < 32; ++e) { const int n = (tot[e] + 255) >> 8; for (int i = 0; i < n; ++i) TT[1 + tstart[e] + i] = e; } } }
    __syncthreads();
    for (int tile = F.bid; tile < 256; tile += F.G) {
        if (F.tid < 32) { int s = 0; for (int w2 = 0; w2 < tile; ++w2) s += cl[w2 * 32 + F.tid]; base[F.tid] = s; }
        __syncthreads();
        if (F.tid < 256) { const int a = 2 * tile * 128 + F.tid; const int e = ASGE[a]; const int pos = tstart[e] * 256 + base[e] + ASGR[a]; DEST[a] = pos; ROWTOK[pos] = a >> 1; }
        __syncthreads();
    }
    for (int e = F.bid; e < 32; e += F.G) { const int n = (tot[e] + 255) >> 8; for (int p = tot[e] + F.tid; p < n * 256; p += 512) ROWTOK[tstart[e] * 256 + p] = 0; }
    __syncthreads();
}
__device__ __forceinline__ void ph_moe1(ArgP ap, const Frame& F_) {
    ap = launder(ap); unsigned char* ws = ap->ws; const Frame F = relaunder(F_);
    const int* TT = (const int*)(ws + SM_TT);
    LAS int* tt = (LAS int*)(F.lds + LDS_TT);
    __syncthreads();
    for (int idx = F.tid; idx < 1 + NRT_MAX; idx += 512) tt[idx] = TT[idx];
    __syncthreads();
    Moe1Sched S{(const char*)(ws + WS_H), (const char*)(ws + WS_WGU), (const int*)(ws + SM_ROWTOK), tt, F.G, F.bid};
    EpiSwiGLU E{(bf16_t*)(ws + WS_HID)};
    pg8::gemm_phase(F.lds, S, E);
}
__device__ __forceinline__ void ph_moe2(ArgP ap, const Frame& F_) {
    ap = launder(ap); unsigned char* ws = ap->ws; const Frame F = relaunder(F_);
    const int* TT = (const int*)(ws + SM_TT);
    LAS int* tt = (LAS int*)(F.lds + LDS_TT);
    __syncthreads();
    for (int idx = F.tid; idx < 1 + NRT_MAX; idx += 512) tt[idx] = TT[idx];
    __syncthreads();
    Moe2Sched S{(const char*)(ws + WS_HID), (const char*)(ws + WS_WD), tt, F.G, F.bid};
    EpiPlain E{(bf16_t*)(ws + WS_YBUF), 2048, (size_t)256 * 2048, 256};
    pg8::gemm_phase(F.lds, S, E);
}
__device__ __forceinline__ void ph_combine(ArgP ap, const Frame& F_, const int layer) {
    ap = launder(ap); unsigned char* ws = ap->ws; const Frame F = relaunder(F_);
    const bf16_t* yb = (const bf16_t*)(ws + WS_YBUF); float* xres = ap->out; bf16_t* Hb = (bf16_t*)(ws + WS_H);
    const int* DEST = (const int*)(ws + SM_DEST); const float* ASGW = (const float*)(ws + SM_ASGW);
    const float* gain = layer == 0 ? INP(float, 12) : INP(float, 24);
    for (int m = F.bid * 8 + F.wave; m < T; m += F.G * 8) {
        const int d0 = DEST[2 * m], d1 = DEST[2 * m + 1]; const float w0 = ASGW[2 * m], w1 = ASGW[2 * m + 1];
        f32x4* xr = (f32x4*)(xres + (size_t)m * D) + F.lane; const f32x4* gr = (const f32x4*)gain + F.lane;
        const u32x2* y0p = (const u32x2*)(yb + (size_t)d0 * D) + F.lane; const u32x2* y1p = (const u32x2*)(yb + (size_t)d1 * D) + F.lane;
        f32x4 v[8]; float s = 0.f;
#pragma unroll
        for (int j = 0; j < 8; ++j) { const f32x4 xv = xr[64 * j]; const u32x2 a = y0p[64 * j], c = y1p[64 * j];
            v[j].x = xv.x + w0 * bf_lo(a.x) + w1 * bf_lo(c.x); v[j].y = xv.y + w0 * bf_hi(a.x) + w1 * bf_hi(c.x);
            v[j].z = xv.z + w0 * bf_lo(a.y) + w1 * bf_lo(c.y); v[j].w = xv.w + w0 * bf_hi(a.y) + w1 * bf_hi(c.y);
            s += (v[j].x * v[j].x + v[j].y * v[j].y) + (v[j].z * v[j].z + v[j].w * v[j].w); }
        const float rstd = 1.0f / sqrtf(wave_sum(s) * (1.0f / D) + EPS);
        if (layer == 0) {
            u32x2* o8 = (u32x2*)(Hb + (size_t)m * D) + F.lane;
#pragma unroll
            for (int j = 0; j < 8; ++j) { xr[64 * j] = v[j]; const f32x4 g = gr[64 * j]; u32x2 w; w.x = pk2(v[j].x * rstd * g.x, v[j].y * rstd * g.y); w.y = pk2(v[j].z * rstd * g.z, v[j].w * rstd * g.w); o8[64 * j] = w; }
        } else {
#pragma unroll
            for (int j = 0; j < 8; ++j) { const f32x4 g = gr[64 * j]; f32x4 o; o.x = v[j].x * rstd * g.x; o.y = v[j].y * rstd * g.y; o.z = v[j].z * rstd * g.z; o.w = v[j].w * rstd * g.w; xr[64 * j] = o; }
        }
    }
}

#ifndef PH_MASK
#define PH_MASK 0xffffffffull
#endif
#define SITE(s) ((PH_MASK >> (s)) & 1ull)
__global__ void __launch_bounds__(512, 2) mk_fwd(Args args) {
    extern __shared__ __attribute__((aligned(16))) unsigned char lds_raw[];
    ArgP ap = (ArgP)__builtin_amdgcn_kernarg_segment_ptr();
    Frame F;
    F.lds = (LAS unsigned char*)lds_raw;
    F.tid = threadIdx.x; F.lane = F.tid & 63; F.wave = __builtin_amdgcn_readfirstlane(F.tid >> 6); F.G = gridDim.x; F.bid = blockIdx.x;
    volatile LAS unsigned* MISC = (volatile LAS unsigned*)(F.lds + LDS_MISC);
    if (F.tid < 64) MISC[F.tid] = 0u;
    __syncthreads();
    const int lo = ap->ph_lo, hi = ap->ph_hi;
    XcdBarrier bar = xcd_barrier_post((unsigned*)(ap->ws + WS_CTL) + CW_BAR + ap->li * XCD_BAR_WORDS, MISC + 8);
#define IN(k) (SITE(k) && lo <= (k) && (k) < hi)
#define SEAM(k) do { if ((k) + 1 < hi) xcd_barrier(bar); } while (0)
#ifndef REP_MASK
#define REP_MASK 0ull
#endif
#define RUN(k, call) if (IN(k)) { call; if constexpr (((REP_MASK >> (k)) & 1ull) != 0ull) { xcd_barrier(bar); call; } SEAM(k); }
    RUN(0, ph_prologue(ap, F))
    RUN(1, ph_inproj0(ap, F))
    RUN(2, ph_conv_attn(ap, F))
    RUN(3, ph_gates(ap, F))
    RUN(4, ph_scan(ap, F, 0))
    RUN(5, ph_scan(ap, F, 1))
    RUN(6, ph_outproj0(ap, F))
#define MOE_HALF(layer, p0) \
    RUN((p0) + 0, ph_router(ap, F, layer)) \
    RUN((p0) + 1, ph_dispatch(ap, F)) \
    RUN((p0) + 2, ph_moe1(ap, F)) \
    RUN((p0) + 3, ph_moe2(ap, F)) \
    RUN((p0) + 4, ph_combine(ap, F, layer))
#define L1_MIXER(b, p0) \
    RUN((p0) + 0, ph_l1_inproj(ap, F, b)) \
    RUN((p0) + 1, ph_l1_kv(ap, F)) \
    RUN((p0) + 2, ph_l1_rscan(ap, F)) \
    RUN((p0) + 3, ph_l1_y(ap, F)) \
    RUN((p0) + 4, ph_l1_gnorm(ap, F, b)) \
    RUN((p0) + 5, ph_l1_out(ap, F, b))
    MOE_HALF(0, 7)
    L1_MIXER(0, 12)
    L1_MIXER(1, 18)
    MOE_HALF(1, 24)
#ifdef XBAR_PROBE
    for (int i = 0; i < XBAR_PROBE; ++i) xcd_barrier(bar);
#endif
#undef MOE_HALF
#undef L1_MIXER
#undef IN
#undef SEAM
}

constexpr int N_PHASES = 29;
#ifndef MK_PER_PHASE
#define MK_PER_PHASE 0
#endif
extern "C" void kernel_launch(void* const* d_in, const int* in_sizes, int n_in, void* d_out, int out_size, void* d_ws, size_t ws_size, hipStream_t stream) {
    static int grid = 0;
    if (grid == 0) {
        if (n_in != 25 || out_size != T * D || ws_size < WS_END) { fprintf(stderr, "kernel_launch: unexpected shapes (n_in %d out %d ws %zu)\n", n_in, out_size, ws_size); grid = -1; return; }
        int dev = 0, cus = 0, per_cu = 0;
        if (hipGetDevice(&dev) != hipSuccess || hipDeviceGetAttribute(&cus, hipDeviceAttributeMultiprocessorCount, dev) != hipSuccess) { grid = -1; return; }
        if (hipFuncSetAttribute((const void*)mk_fwd, hipFuncAttributeMaxDynamicSharedMemorySize, LDS_BYTES) != hipSuccess) { fprintf(stderr, "kernel_launch: hipFuncSetAttribute failed\n"); grid = -1; return; }
        if (hipOccupancyMaxActiveBlocksPerMultiprocessor(&per_cu, (const void*)mk_fwd, 512, LDS_BYTES) != hipSuccess || per_cu < 1) fprintf(stderr, "kernel_launch: occupancy query reports %d\n", per_cu);
        (void)hipGetLastError();
        grid = cus;
    }
    if (grid < 0) return;
    (void)hipMemsetAsync((char*)d_ws + WS_CTL, 0, CTL_ZERO_BYTES, stream);
    Args a; memset(&a, 0, sizeof(a));
    for (int i = 0; i < 25; ++i) a.in[i] = d_in[i];
    a.out = (float*)d_out; a.ws = (unsigned char*)d_ws;
#if MK_PER_PHASE
    for (int p = 0; p < N_PHASES; ++p) { a.ph_lo = p; a.ph_hi = p + 1; a.li = 0; hipLaunchKernelGGL(mk_fwd, dim3(grid), dim3(512), LDS_BYTES, stream, a); }
#else
    a.ph_lo = 0; a.ph_hi = N_PHASES; a.li = 0;
    hipLaunchKernelGGL(mk_fwd, dim3(grid), dim3(512), LDS_BYTES, stream, a);
#endif
}
```

```cpp
#include <hip/hip_runtime.h>
#include <cstdio>
#include <cstdint>
#include <cstring>

#define LAS __attribute__((address_space(3)))
#define GAS __attribute__((address_space(1)))
typedef unsigned short bf16_t;
typedef short bf16x8 __attribute__((ext_vector_type(8)));
typedef float f32x4 __attribute__((ext_vector_type(4)));
typedef float f32x2 __attribute__((ext_vector_type(2)));
typedef unsigned u32x4 __attribute__((ext_vector_type(4)));
typedef unsigned u32x2 __attribute__((ext_vector_type(2)));

constexpr int T = 32768, D = 2048, SEQ = 16384;
constexpr int EV_IN = 5120, OD_IN = 12288;
constexpr int PMAX = 65536 + 32 * 256, NRT_MAX = PMAX / 256;
constexpr float EPS = 1e-6f;

constexpr size_t MiB = 1u << 20;
constexpr size_t WS_CTL = 0, CTL_ZERO_BYTES = 1 * MiB;
constexpr size_t WS_SMALL = 1 * MiB;
constexpr size_t SM_CNT = WS_SMALL + 0;
constexpr size_t SM_TT = WS_SMALL + 32 * 1024;
constexpr size_t SM_ASGE = WS_SMALL + 64 * 1024;
constexpr size_t SM_ASGR = WS_SMALL + 320 * 1024;
constexpr size_t SM_ASGW = WS_SMALL + 576 * 1024;
constexpr size_t SM_DEST = WS_SMALL + 832 * 1024;
constexpr size_t SM_ROWTOK = WS_SMALL + 1088 * 1024;
constexpr size_t WS_ROT = 4 * MiB;
constexpr size_t WS_WOD = 36 * MiB;
constexpr size_t WS_WODO = 84 * MiB;
constexpr size_t WS_WGU = 100 * MiB;
constexpr size_t WS_WD = 228 * MiB;
constexpr size_t WS_WEVI = 292 * MiB;
constexpr size_t WS_WEVO = 312 * MiB;
constexpr size_t WS_WGATE = 320 * MiB;
constexpr size_t WS_SUB = 321 * MiB;
constexpr size_t WS_CH = 329 * MiB;
constexpr size_t WS_H = 332 * MiB;
constexpr size_t ARENA = 460 * MiB;
constexpr size_t WS_PROJ0 = ARENA;
constexpr size_t WS_XC = 780 * MiB;
constexpr size_t WS_GPRE = 844 * MiB;
constexpr size_t WS_Y0 = 972 * MiB;
constexpr size_t WS_HID = ARENA;
constexpr size_t WS_YBUF = 532 * MiB;
constexpr size_t WS_QCAT = ARENA;
constexpr size_t WS_VRCAT = 588 * MiB;
constexpr size_t WS_KB = 844 * MiB;
constexpr size_t WS_KDT = 908 * MiB;
constexpr size_t WS_YB = 844 * MiB;
constexpr size_t WS_GB = 972 * MiB;
constexpr size_t WS_STATS = 292 * MiB;
constexpr size_t WS_END = 1100 * MiB;

constexpr int CW_BAR = 4096;

constexpr int LDS_MAIN = 131072;
constexpr int LDS_MISC = LDS_MAIN;
constexpr int LDS_TT = LDS_MAIN + 256;
constexpr int LDS_BYTES = 147456;

__device__ __forceinline__ unsigned f2bf(float f) { unsigned u = __builtin_bit_cast(unsigned, f); return (u + 0x7fffu + ((u >> 16) & 1u)) >> 16; }
__device__ __forceinline__ unsigned pk2(float lo, float hi) { unsigned r; asm volatile("v_cvt_pk_bf16_f32 %0, %1, %2" : "=v"(r) : "v"(lo), "v"(hi)); return r; }
__device__ __forceinline__ float bf_lo(unsigned w) { return __builtin_bit_cast(float, w << 16); }
__device__ __forceinline__ float bf_hi(unsigned w) { return __builtin_bit_cast(float, w & 0xffff0000u); }
__device__ __forceinline__ float bf2f(bf16_t h) { return __builtin_bit_cast(float, ((unsigned)h) << 16); }
__device__ __forceinline__ float wave_sum(float v) {
#pragma unroll
    for (int o = 1; o < 64; o <<= 1) v += __shfl_xor(v, o);
    return v;
}
__device__ __forceinline__ float sigmoidf_(float x) { return __builtin_amdgcn_rcpf(1.0f + __expf(-x)); }
__device__ __forceinline__ float gelu_tanh(float x) { const float u = 0.7978845608028654f * (x + 0.044715f * x * x * x); const float e = __expf(2.0f * u); const float th = 1.0f - 2.0f * __builtin_amdgcn_rcpf(e + 1.0f); return 0.5f * x * (1.0f + th); }
__device__ __forceinline__ void unpack8(const u32x4 w, float (&f)[8]) { f[0] = bf_lo(w.x); f[1] = bf_hi(w.x); f[2] = bf_lo(w.y); f[3] = bf_hi(w.y); f[4] = bf_lo(w.z); f[5] = bf_hi(w.z); f[6] = bf_lo(w.w); f[7] = bf_hi(w.w); }
__device__ __forceinline__ u32x4 pack8(const float (&f)[8]) { u32x4 w; w.x = pk2(f[0], f[1]); w.y = pk2(f[2], f[3]); w.z = pk2(f[4], f[5]); w.w = pk2(f[6], f[7]); return w; }
#define LDS_WAIT() asm volatile("s_waitcnt lgkmcnt(0)" ::: "memory")

#define XB_TMO      128
#define XB_XCNT(j)  (256  + 64 * (j))
#define XB_XSUB(j)  (1280 + 64 * (j))
#define XB_XGEN(j)  (2304 + 64 * (j))
#define XB_TOP      3328
#define XB_TOPGEN   3392
#define XCD_BAR_WORDS 3456
#define XB_SPIN_CAP (1u << 18)
__device__ __forceinline__ unsigned xb_ld(unsigned* p)              { return __hip_atomic_load(p, __ATOMIC_RELAXED, __HIP_MEMORY_SCOPE_AGENT); }
__device__ __forceinline__ unsigned xb_add(unsigned* p, unsigned v) { return __hip_atomic_fetch_add(p, v, __ATOMIC_RELAXED, __HIP_MEMORY_SCOPE_AGENT); }
__device__ __forceinline__ unsigned xb_xcc_id() { return (unsigned)__builtin_amdgcn_s_getreg((3 << 11) | 20) & 0xFu; }
#define XB_SPIN(cond, bar) do { unsigned _sp = 0; while (cond) { __builtin_amdgcn_s_sleep(1); \
    if ((++_sp & 255u) == 0u) { if (xb_ld(&(bar)[XB_TMO])) break; if (_sp > XB_SPIN_CAP) { atomicAdd(&(bar)[XB_TMO], 1u); break; } } } } while (0)
struct XcdBarrier { unsigned* bar; unsigned x; volatile LAS unsigned* st; };
__device__ __forceinline__ XcdBarrier xcd_barrier_post(unsigned* bar, volatile LAS unsigned* st) {
    XcdBarrier b; b.bar = bar; b.x = xb_xcc_id(); b.st = st;
    if (threadIdx.x == 0) (void)xb_add(&bar[XB_XCNT(b.x)], 1u);
    return b;
}
__device__ __forceinline__ void xcd_barrier_complete(unsigned* bar, unsigned x, unsigned& nloc, unsigned& nx) {
    const unsigned G = gridDim.x * gridDim.y * gridDim.z;
    unsigned sum, cnt, mine, sp = 0u;
    for (;;) {
        sum = 0u; cnt = 0u; mine = 0u;
#pragma unroll
        for (unsigned j = 0; j < 16; ++j) { const unsigned c = xb_ld(&bar[XB_XCNT(j)]); sum += c; cnt += (c > 0u) ? 1u : 0u; mine = (j == x) ? c : mine; }
        if (sum == G) break;
        __builtin_amdgcn_s_sleep(1);
        if ((++sp & 255u) == 0u) { if (xb_ld(&bar[XB_TMO])) break; if (sp > XB_SPIN_CAP) { atomicAdd(&bar[XB_TMO], 1u); break; } }
    }
    nloc = mine > 0u ? mine : 1u; nx = cnt > 0u ? cnt : 1u;
}
__device__ __forceinline__ void xcd_barrier(const XcdBarrier& b) {
    asm volatile("s_waitcnt vmcnt(0)" ::: "memory");
    __syncthreads();
    if (threadIdx.x == 0) {
        unsigned* bar = b.bar;
        __builtin_amdgcn_s_waitcnt(0);
        unsigned nloc = b.st[0], nx = b.st[1];
        if (nloc == 0u) { xcd_barrier_complete(bar, b.x, nloc, nx); b.st[0] = nloc; b.st[1] = nx; }
        const unsigned old = xb_add(&bar[XB_XSUB(b.x)], 1u);
        const unsigned gen = old / nloc;
        if (old + 1u == (gen + 1u) * nloc) {
            __builtin_amdgcn_fence(__ATOMIC_RELEASE, "agent");
            asm volatile("s_waitcnt vmcnt(0)" ::: "memory");
            const unsigned og = xb_add(&bar[XB_TOP], 1u);
            const unsigned tg = og / nx;
            if (og + 1u == (tg + 1u) * nx) xb_add(&bar[XB_TOPGEN], 1u);
            else XB_SPIN(xb_ld(&bar[XB_TOPGEN]) == tg, bar);
            __builtin_amdgcn_fence(__ATOMIC_ACQUIRE, "agent");
            xb_add(&bar[XB_XGEN(b.x)], 1u);
            asm volatile("s_waitcnt vmcnt(0)" ::: "memory");
        } else {
            XB_SPIN(xb_ld(&bar[XB_XGEN(b.x)]) == gen, bar);
            __builtin_amdgcn_fence(__ATOMIC_ACQUIRE, "agent");
            asm volatile("s_waitcnt vmcnt(0)" ::: "memory");
        }
    }
    __syncthreads();
}

namespace pg8 {
constexpr int BM = 256, BK = 64, HALF = 128, HTB = HALF * BK * 2, STAGE_BYTES = 8 * HTB, NXCD = 8, WGM = 8;
__device__ __forceinline__ int lds_byte(int r, int c) { const int st = (r >> 4) * 2 + (c >> 5), rr = r & 15, cc = c & 31, ob = rr * 64 + cc * 2; return st * 1024 + (ob ^ (((ob >> 9) & 1) << 5)); }
__device__ __forceinline__ void stage_rc(int b, int& R, int& C) { const int st = b / 1024, sb = b % 1024, swz = sb ^ (((sb >> 9) & 1) << 5); R = (st >> 1) * 16 + swz / 64; C = (st & 1) * 32 + (swz % 64) / 2; }
__device__ __forceinline__ int perm32(int rho) { const int n = rho >> 4, i = rho & 15; return 8 * (i >> 2) + 4 * n + (i & 3); }

struct Unit { const char* a; const char* b; int pm, pn, x0, x1; };

__device__ __forceinline__ void tile_order(int L, int nM, int nN, int& pm, int& pn) {
    const int nwg = nM * nN; int wgid = L;
    { const int q = nwg / NXCD, r = nwg % NXCD, xcd = wgid % NXCD, off = wgid / NXCD; wgid = (xcd < r ? xcd * (q + 1) : r * (q + 1) + (xcd - r) * q) + off; }
    const int nig = WGM * nN, gid = wgid / nig, fm = gid * WGM, gsz = (nM - fm) < WGM ? (nM - fm) : WGM;
    pm = fm + ((wgid % nig) % gsz); pn = (wgid % nig) / gsz;
}

template <class Epi, class Sched>
__device__ __forceinline__ void gemm_phase(LAS unsigned char* lds, const Sched& S, const Epi& E) {
    int tid_ = threadIdx.x; asm volatile("" : "+v"(tid_));
    const int tid = tid_, wid = __builtin_amdgcn_readfirstlane(tid >> 6), lane = tid & 63, wr = wid >> 2, wc = wid & 3, fr = lane & 15, fq = lane >> 4;
    const int nt = S.K / BK;
    int sR[2], sC[2];
    unsigned voffB[2];
#pragma unroll
    for (int i = 0; i < 2; ++i) { stage_rc(tid * 16 + i * 8192, sR[i], sC[i]); const int Rb = Epi::PERM ? ((sR[i] & ~31) + perm32(sR[i] & 31)) : sR[i];
        voffB[i] = (unsigned)(Rb * S.ldb + sC[i]) * 2u; }
    const size_t kstep = (size_t)(BK * 2);
    const size_t hstepB = (size_t)HALF * S.ldb * 2, hstepA = (size_t)HALF * S.lda * 2;
    const unsigned ldsw = (unsigned)wid * 1024u;
    const int aoff = lds_byte(wr * 64 + fr, fq * 8), boff = lds_byte(wc * 32 + fr, fq * 8);
#define PG8_SA(b, h) (((b) * 2 + (h)) * HTB)
#define PG8_SB(b, h) ((4 + (b) * 2 + (h)) * HTB)
#define PG8_STAGE2(bufoff, gbase, v0, v1) do { \
        __builtin_amdgcn_global_load_lds((const unsigned*)((const char*)(gbase) + (v0)), (LAS unsigned*)(lds + (bufoff) + ldsw), 16, 0, 0); \
        __builtin_amdgcn_global_load_lds((const unsigned*)((const char*)(gbase) + (v1)), (LAS unsigned*)(lds + (bufoff) + ldsw + 8192), 16, 0, 0); } while (0)
#define PG8_STAGEB(b, h, gbase) PG8_STAGE2(PG8_SB(b, h), (gbase) + (h) * hstepB, voffB[0], voffB[1])
#define PG8_STAGEA(b, h, gbase, V) do { if constexpr (Sched::GATHER) { PG8_STAGE2(PG8_SA(b, h), gbase, V[h][0], V[h][1]); } else { PG8_STAGE2(PG8_SA(b, h), (gbase) + (h) * hstepA, V[0][0], V[0][1]); } } while (0)
#define PG8_LDA(dst, b, h) do { _Pragma("unroll") for (int m = 0; m < 4; ++m) _Pragma("unroll") for (int k = 0; k < 2; ++k) dst[m][k] = *(const LAS bf16x8*)(lds + PG8_SA(b, h) + aoff + m * 2048 + k * 1024); } while (0)
#define PG8_LDB(dst, b, h) do { _Pragma("unroll") for (int n = 0; n < 2; ++n) _Pragma("unroll") for (int k = 0; k < 2; ++k) dst[n][k] = *(const LAS bf16x8*)(lds + PG8_SB(b, h) + boff + n * 2048 + k * 1024); } while (0)
#define PG8_MMA(ai, bj, At, Bt) do { __builtin_amdgcn_s_setprio(1); _Pragma("unroll") for (int m = 0; m < 4; ++m) _Pragma("unroll") for (int n = 0; n < 2; ++n) _Pragma("unroll") for (int k = 0; k < 2; ++k) \
        acc[ai][bj][m][n] = __builtin_amdgcn_mfma_f32_16x16x32_bf16(Bt[n][k], At[m][k], acc[ai][bj][m][n], 0, 0, 0); __builtin_amdgcn_s_setprio(0); } while (0)
#define PG8_WAIT_V(n) asm volatile("s_waitcnt vmcnt(" #n ")" ::: "memory")
#define PG8_WAIT_L(n) asm volatile("s_waitcnt lgkmcnt(" #n ")" ::: "memory")
#define PG8_BAR __builtin_amdgcn_s_barrier()
#define PG8_SCHED __builtin_amdgcn_sched_barrier(0)
#define PG8_CALC_VA(u, V) do { _Pragma("unroll") for (int _h = 0; _h < 2; ++_h) _Pragma("unroll") for (int _i = 0; _i < 2; ++_i) { \
        if constexpr (Sched::GATHER) V[_h][_i] = S.row_off(u, sR[_i] + HALF * _h) + (unsigned)sC[_i] * 2u; \
        else V[_h][_i] = (unsigned)((sR[_i] + HALF * _h) * S.lda + sC[_i]) * 2u; } } while (0)
    Unit cur, nxt; int ui = 0;
    if (!S.next(0, cur)) return;
    f32x4 acc[2][2][4][2];
#pragma unroll
    for (int a = 0; a < 2; ++a)
#pragma unroll
        for (int b = 0; b < 2; ++b)
#pragma unroll
            for (int m = 0; m < 4; ++m)
#pragma unroll
                for (int n = 0; n < 2; ++n) acc[a][b][m][n] = (f32x4){0.f, 0.f, 0.f, 0.f};
    bf16x8 At[4][2], B0[2][2], B1[2][2];
    unsigned vA[2][2], vN[2][2];
    PG8_CALC_VA(cur, vA);
    const char* cA = cur.a; const char* cB = cur.b;
    PG8_STAGEB(0, 0, cB); PG8_STAGEB(0, 1, cB); PG8_STAGEA(0, 0, cA, vA); PG8_STAGEA(0, 1, cA, vA);
    if (wr == 1) PG8_BAR;
    PG8_WAIT_V(2); PG8_BAR;
    PG8_STAGEB(1, 0, cB + kstep); PG8_STAGEA(1, 0, cA + kstep, vA); PG8_STAGEB(1, 1, cB + kstep);
    PG8_WAIT_V(6); PG8_BAR;
    for (;;) {
        const bool has_next = S.next(ui + 1, nxt);
        const char* nA = has_next ? nxt.a : cA; const char* nB = has_next ? nxt.b : cB;
        if constexpr (Sched::GATHER) { if (has_next) { PG8_CALC_VA(nxt, vN); } else {
#pragma unroll
            for (int _h = 0; _h < 2; ++_h)
#pragma unroll
                for (int _i = 0; _i < 2; ++_i) vN[_h][_i] = vA[_h][_i]; } }
#pragma unroll 1
        for (int t = 0; t < nt; t += 2) {
            const bool last = (t == nt - 2);
            const char* a1 = cA + (size_t)(t + 1) * kstep;
            const char* a2 = last ? nA : cA + (size_t)(t + 2) * kstep; const char* b2 = last ? nB : cB + (size_t)(t + 2) * kstep;
            const char* a3 = a2 + kstep; const char* b3 = b2 + kstep;
            unsigned vS[2][2];
#pragma unroll
            for (int _h = 0; _h < 2; ++_h)
#pragma unroll
                for (int _i = 0; _i < 2; ++_i) { if constexpr (Sched::GATHER) vS[_h][_i] = last ? vN[_h][_i] : vA[_h][_i]; else vS[_h][_i] = vA[_h][_i]; }
            PG8_LDB(B0, 0, 0); PG8_LDB(B1, 0, 1); PG8_SCHED; PG8_LDA(At, 0, 0); PG8_STAGEA(1, 1, a1, vA);
            PG8_WAIT_V(8); PG8_WAIT_L(0); PG8_BAR; PG8_MMA(0, 0, At, B0); PG8_MMA(0, 1, At, B1); PG8_BAR; PG8_SCHED;
            PG8_LDA(At, 0, 1); PG8_STAGEB(0, 0, b2); PG8_STAGEB(0, 1, b2); PG8_STAGEA(0, 0, a2, vS);
            PG8_WAIT_V(8); PG8_WAIT_L(0); PG8_BAR; PG8_MMA(1, 0, At, B0); PG8_MMA(1, 1, At, B1); PG8_BAR; PG8_SCHED;
            PG8_LDB(B0, 1, 0); PG8_LDB(B1, 1, 1); PG8_SCHED; PG8_LDA(At, 1, 0); PG8_STAGEA(0, 1, a2, vS);
            PG8_WAIT_V(8); PG8_WAIT_L(0); PG8_BAR; PG8_MMA(0, 0, At, B0); PG8_MMA(0, 1, At, B1); PG8_BAR; PG8_SCHED;
            PG8_LDA(At, 1, 1); PG8_STAGEB(1, 0, b3); PG8_STAGEB(1, 1, b3); PG8_STAGEA(1, 0, a3, vS);
            PG8_WAIT_V(8); PG8_WAIT_L(0); PG8_BAR; PG8_MMA(1, 0, At, B0); PG8_MMA(1, 1, At, B1); PG8_BAR; PG8_SCHED;
        }
        if (wr == 0) PG8_BAR;
        E(acc, cur, wr, wc, fr, fq);
        if (!has_next) break;
#pragma unroll
        for (int a = 0; a < 2; ++a)
#pragma unroll
            for (int b = 0; b < 2; ++b)
#pragma unroll
                for (int m = 0; m < 4; ++m)
#pragma unroll
                    for (int n = 0; n < 2; ++n) acc[a][b][m][n] = (f32x4){0.f, 0.f, 0.f, 0.f};
        cur = nxt; cA = nA; cB = nB; ++ui;
        if constexpr (Sched::GATHER) {
#pragma unroll
            for (int _h = 0; _h < 2; ++_h)
#pragma unroll
                for (int _i = 0; _i < 2; ++_i) vA[_h][_i] = vN[_h][_i]; }
        if (wr == 1) PG8_BAR;
    }
    PG8_WAIT_V(0);
    PG8_BAR;
#undef PG8_SA
#undef PG8_SB
#undef PG8_STAGE2
#undef PG8_STAGEA
#undef PG8_STAGEB
#undef PG8_LDA
#undef PG8_LDB
#undef PG8_MMA
#undef PG8_WAIT_V
#undef PG8_WAIT_L
#undef PG8_BAR
#undef PG8_SCHED
#undef PG8_CALC_VA
}

template <int nM, int nN, int LDA, int LDB, int KK>
struct DenseSched {
    static constexpr bool GATHER = false;
    static constexpr int K = KK, lda = LDA, ldb = LDB;
    const char* A; const char* B; int G, c;
    __device__ __forceinline__ bool next(int i, Unit& u) const {
        const int L = i * G + c; if (L >= nM * nN) return false;
        int pm, pn; tile_order(L, nM, nN, pm, pn);
        u.pm = pm; u.pn = pn; u.x0 = 0; u.x1 = 0; u.a = A + (size_t)pm * BM * lda * 2; u.b = B + (size_t)pn * BM * ldb * 2; return true;
    }
    __device__ __forceinline__ unsigned row_off(const Unit&, int) const { return 0u; }
};
}

typedef const f32x4 (&AccRef)[2][2][4][2];

struct EpiPlain {
    static constexpr bool PERM = true;
    bf16_t* out; int ldc; size_t pm_stride, pn_stride;
    __device__ __forceinline__ void operator()(AccRef acc, const pg8::Unit& u, int wr, int wc, int fr, int fq) const {
        bf16_t* tile = out + (size_t)u.pm * pm_stride + (size_t)u.pn * pn_stride;
        int r0 = wr * 64 + fr, c0 = wc * 32 + 8 * fq; asm volatile("" : "+v"(r0), "+v"(c0));
#pragma unroll
        for (int ai = 0; ai < 2; ++ai)
#pragma unroll
            for (int m = 0; m < 4; ++m) { bf16_t* rowp = tile + (size_t)(r0 + ai * 128 + m * 16) * ldc + c0;
#pragma unroll
                for (int bj = 0; bj < 2; ++bj) { const f32x4 v0 = acc[ai][bj][m][0], v1 = acc[ai][bj][m][1];
                    u32x4 w; w.x = pk2(v0[0], v0[1]); w.y = pk2(v0[2], v0[3]); w.z = pk2(v1[0], v1[1]); w.w = pk2(v1[2], v1[3]);
                    *(u32x4*)(rowp + bj * 128) = w; } }
    }
};
struct EpiUnitPtr {
    static constexpr bool PERM = true;
    bf16_t* out; int ldc;
    __device__ __forceinline__ void operator()(AccRef acc, const pg8::Unit& u, int wr, int wc, int fr, int fq) const {
        bf16_t* tile = out + (((size_t)(unsigned)u.x1 << 32) | (size_t)(unsigned)u.x0);
        int r0 = wr * 64 + fr, c0 = wc * 32 + 8 * fq; asm volatile("" : "+v"(r0), "+v"(c0));
#pragma unroll
        for (int ai = 0; ai < 2; ++ai)
#pragma unroll
            for (int m = 0; m < 4; ++m) { bf16_t* rowp = tile + (size_t)(r0 + ai * 128 + m * 16) * ldc + c0;
#pragma unroll
                for (int bj = 0; bj < 2; ++bj) { const f32x4 v0 = acc[ai][bj][m][0], v1 = acc[ai][bj][m][1];
                    u32x4 w; w.x = pk2(v0[0], v0[1]); w.y = pk2(v0[2], v0[3]); w.z = pk2(v1[0], v1[1]); w.w = pk2(v1[2], v1[3]);
                    *(u32x4*)(rowp + bj * 128) = w; } }
    }
};
struct EpiResid {
    static constexpr bool PERM = false;
    const float* base; float* out; int row0;
    __device__ __forceinline__ void operator()(AccRef acc, const pg8::Unit& u, int wr, int wc, int fr, int fq) const {
        int r0 = row0 + u.pm * 256 + wr * 64 + fr, c0 = u.pn * 256 + wc * 32 + 4 * fq; asm volatile("" : "+v"(r0), "+v"(c0));
#pragma unroll
        for (int ai = 0; ai < 2; ++ai)
#pragma unroll
            for (int m = 0; m < 4; ++m) { const size_t off = (size_t)(r0 + ai * 128 + m * 16) * D + c0;
#pragma unroll
                for (int bj = 0; bj < 2; ++bj)
#pragma unroll
                    for (int n = 0; n < 2; ++n) { const f32x4 bs = *(const f32x4*)(base + off + bj * 128 + n * 16); *(f32x4*)(out + off + bj * 128 + n * 16) = bs + acc[ai][bj][m][n]; }
                asm volatile("" ::: "memory"); }
    }
};
struct EpiSwiGLU {
    static constexpr bool PERM = true;
    bf16_t* hid;
    __device__ __forceinline__ void operator()(AccRef acc, const pg8::Unit& u, int wr, int wc, int fr, int fq) const {
        bf16_t* tile = hid + (size_t)u.pm * 256 * 512 + u.pn * 128;
        int r0 = wr * 64 + fr, c0 = wc * 32 + 8 * fq; asm volatile("" : "+v"(r0), "+v"(c0));
#pragma unroll
        for (int ai = 0; ai < 2; ++ai)
#pragma unroll
            for (int m = 0; m < 4; ++m) { bf16_t* rowp = tile + (size_t)(r0 + ai * 128 + m * 16) * 512 + c0;
                float o[8];
#pragma unroll
                for (int n = 0; n < 2; ++n)
#pragma unroll
                    for (int j = 0; j < 4; ++j) { const float g = acc[ai][0][m][n][j], up = acc[ai][1][m][n][j]; o[n * 4 + j] = g * sigmoidf_(g) * up; }
                *(u32x4*)rowp = pack8(o); }
    }
};
struct EpiSilu {
    static constexpr bool PERM = true;
    bf16_t* out; int ldc;
    __device__ __forceinline__ void operator()(AccRef acc, const pg8::Unit& u, int wr, int wc, int fr, int fq) const {
        bf16_t* tile = out + (size_t)u.pm * 256 * ldc + u.pn * 256;
        int r0 = wr * 64 + fr, c0 = wc * 32 + 8 * fq; asm volatile("" : "+v"(r0), "+v"(c0));
#pragma unroll
        for (int ai = 0; ai < 2; ++ai)
#pragma unroll
            for (int m = 0; m < 4; ++m) { bf16_t* rowp = tile + (size_t)(r0 + ai * 128 + m * 16) * ldc + c0;
#pragma unroll
                for (int bj = 0; bj < 2; ++bj) { float o[8];
#pragma unroll
                    for (int n = 0; n < 2; ++n)
#pragma unroll
                        for (int j = 0; j < 4; ++j) { const float g = acc[ai][bj][m][n][j]; o[n * 4 + j] = g * sigmoidf_(g); }
                    *(u32x4*)(rowp + bj * 128) = pack8(o); } }
    }
};
struct EpiRotary {
    static constexpr bool PERM = true;
    bf16_t* out; int ldc; size_t pm_stride, pn_stride; const float* rot; int tok0; float scale;
    __device__ __forceinline__ void operator()(AccRef acc, const pg8::Unit& u, int wr, int wc, int fr, int fq) const {
        bf16_t* tile = out + (size_t)u.pm * pm_stride + (size_t)u.pn * pn_stride;
        int r0 = wr * 64 + fr, c0 = wc * 32 + 8 * fq; asm volatile("" : "+v"(r0), "+v"(c0));
#pragma unroll
        for (int ai = 0; ai < 2; ++ai)
#pragma unroll
            for (int m = 0; m < 4; ++m) { const int r = r0 + ai * 128 + m * 16; bf16_t* rowp = tile + (size_t)r * ldc + c0;
                const float* rt = rot + ((size_t)(tok0 + u.pm * 256 + r) * 128 + (c0 >> 1)) * 2;
#pragma unroll
                for (int bj = 0; bj < 2; ++bj) { const f32x4 cs0 = *(const f32x4*)(rt + bj * 128), cs1 = *(const f32x4*)(rt + bj * 128 + 4);
                    const f32x4 v0 = acc[ai][bj][m][0], v1 = acc[ai][bj][m][1]; float o[8];
                    o[0] = (v0[0] * cs0[0] - v0[1] * cs0[1]) * scale; o[1] = (v0[1] * cs0[0] + v0[0] * cs0[1]) * scale;
                    o[2] = (v0[2] * cs0[2] - v0[3] * cs0[3]) * scale; o[3] = (v0[3] * cs0[2] + v0[2] * cs0[3]) * scale;
                    o[4] = (v1[0] * cs1[0] - v1[1] * cs1[1]) * scale; o[5] = (v1[1] * cs1[0] + v1[0] * cs1[1]) * scale;
                    o[6] = (v1[2] * cs1[2] - v1[3] * cs1[3]) * scale; o[7] = (v1[3] * cs1[2] + v1[2] * cs1[3]) * scale;
                    *(u32x4*)(rowp + bj * 128) = pack8(o); } }
    }
};
struct EpiSprime {
    static constexpr bool PERM = true;
    bf16_t* qcat;
    __device__ __forceinline__ void operator()(AccRef acc, const pg8::Unit& u, int wr, int wc, int fr, int fq) const {
        bf16_t* tile = qcat + ((size_t)u.x0 * 16384 + (size_t)u.pm * 256) * 512;
        const float l2g = __log2f(1.0f - exp2f(-5.0f - (float)u.x0));
        int r0 = wr * 64 + fr, c0 = wc * 32 + 8 * fq; asm volatile("" : "+v"(r0), "+v"(c0));
#pragma unroll
        for (int bj = 0; bj < 2; ++bj) {
            float cf[8];
#pragma unroll
            for (int j = 0; j < 8; ++j) cf[j] = __builtin_amdgcn_exp2f(-(float)(c0 + bj * 128 + j + 1) * l2g);
#pragma unroll
            for (int ai = 0; ai < 2; ++ai)
#pragma unroll
                for (int m = 0; m < 4; ++m) { const int r = r0 + ai * 128 + m * 16; bf16_t* rowp = tile + (size_t)r * 512 + c0; float o[8];
#pragma unroll
                    for (int n = 0; n < 2; ++n)
#pragma unroll
                        for (int j = 0; j < 4; ++j) { const int c = c0 + bj * 128 + n * 4 + j; const unsigned keep = ~(unsigned)((r - c) >> 31);
                            o[n * 4 + j] = __builtin_bit_cast(float, __builtin_bit_cast(unsigned, acc[ai][bj][m][n][j] * cf[n * 4 + j]) & keep); }
                    *(u32x4*)(rowp + bj * 128) = pack8(o); }
        }
    }
};
struct EpiY {
    static constexpr bool PERM = true;
    bf16_t* yb; f32x2* stats;
    __device__ __forceinline__ void operator()(AccRef acc, const pg8::Unit& u, int wr, int wc, int fr, int fq) const {
        bf16_t* tile = yb + (size_t)u.pm * 256 * 4096 + u.x0 * 512 + u.pn * 256;
        const float l2g = __log2f(1.0f - exp2f(-5.0f - (float)u.x0));
        int r0 = wr * 64 + fr, c0 = wc * 32 + 8 * fq; asm volatile("" : "+v"(r0), "+v"(c0));
#pragma unroll
        for (int ai = 0; ai < 2; ++ai)
#pragma unroll
            for (int m = 0; m < 4; ++m) { const int r = r0 + ai * 128 + m * 16; bf16_t* rowp = tile + (size_t)r * 4096 + c0; const float rf = __builtin_amdgcn_exp2f((float)(r + 1) * l2g);
                float s1 = 0.f, s2 = 0.f;
#pragma unroll
                for (int bj = 0; bj < 2; ++bj) { const f32x4 v0 = acc[ai][bj][m][0] * rf, v1 = acc[ai][bj][m][1] * rf;
                    s1 += (v0[0] + v0[1]) + (v0[2] + v0[3]) + (v1[0] + v1[1]) + (v1[2] + v1[3]);
                    s2 += (v0[0] * v0[0] + v0[1] * v0[1]) + (v0[2] * v0[2] + v0[3] * v0[3]) + (v1[0] * v1[0] + v1[1] * v1[1]) + (v1[2] * v1[2] + v1[3] * v1[3]);
                    u32x4 w; w.x = pk2(v0[0], v0[1]); w.y = pk2(v0[2], v0[3]); w.z = pk2(v1[0], v1[1]); w.w = pk2(v1[2], v1[3]);
                    *(u32x4*)(rowp + bj * 128) = w; }
                s1 += __shfl_xor(s1, 16); s2 += __shfl_xor(s2, 16); s1 += __shfl_xor(s1, 32); s2 += __shfl_xor(s2, 32);
                if (fq == 0) { f32x2 st; st.x = s1; st.y = s2; stats[((size_t)(u.pm * 256 + r) * 8 + u.x0) * 8 + u.pn * 4 + wc] = st; } }
    }
};
struct EpiGnorm {
    static constexpr bool PERM = true;
    bf16_t* yb; const f32x2* stats; const float* gain;
    __device__ __forceinline__ void operator()(AccRef acc, const pg8::Unit& u, int wr, int wc, int fr, int fq) const {
        const int h = u.pn >> 1;
        bf16_t* tile = yb + (size_t)u.pm * 256 * 4096 + u.pn * 256;
        const float* gn = gain + u.pn * 256;
        int r0 = wr * 64 + fr, c0 = wc * 32 + 8 * fq; asm volatile("" : "+v"(r0), "+v"(c0));
#pragma unroll
        for (int ai = 0; ai < 2; ++ai)
#pragma unroll
            for (int m = 0; m < 4; ++m) { const int r = r0 + ai * 128 + m * 16; bf16_t* rowp = tile + (size_t)r * 4096 + c0;
                const f32x4* sp = (const f32x4*)(stats + ((size_t)(u.pm * 256 + r) * 8 + h) * 8);
                const f32x4 a0 = sp[0], a1 = sp[1], a2 = sp[2], a3 = sp[3];
                const float s1 = (a0.x + a0.z) + (a1.x + a1.z) + (a2.x + a2.z) + (a3.x + a3.z), s2 = (a0.y + a0.w) + (a1.y + a1.w) + (a2.y + a2.w) + (a3.y + a3.w);
                const float mu = s1 * (1.0f / 512.0f); const float rstd = __builtin_amdgcn_rsqf(fmaxf(s2 * (1.0f / 512.0f) - mu * mu, 0.f) + EPS);
#pragma unroll
                for (int bj = 0; bj < 2; ++bj) { float y[8]; unpack8(*(const u32x4*)(rowp + bj * 128), y);
                    const f32x4 g0 = *(const f32x4*)(gn + c0 + bj * 128), g1 = *(const f32x4*)(gn + c0 + bj * 128 + 4);
                    const float gg[8] = {g0.x, g0.y, g0.z, g0.w, g1.x, g1.y, g1.z, g1.w}; float o[8];
#pragma unroll
                    for (int n = 0; n < 2; ++n)
#pragma unroll
                        for (int j = 0; j < 4; ++j) { const float g = acc[ai][bj][m][n][j]; o[n * 4 + j] = g * sigmoidf_(g) * ((y[n * 4 + j] - mu) * rstd * gg[n * 4 + j]); }
                    *(u32x4*)(rowp + bj * 128) = pack8(o); } }
    }
};
struct EpiRotaryT {
    static constexpr bool PERM = true;
    bf16_t* out; bf16_t* kdt; const float* rot; int tok0; float scale;
    __device__ __forceinline__ void operator()(AccRef acc, const pg8::Unit& u, int wr, int wc, int fr, int fq) const {
        bf16_t* tile = out + (size_t)u.pm * 256 * 2048 + (size_t)u.pn * 256;
        bf16_t* ttile = kdt + (size_t)u.pn * 256 * 16384 + (size_t)u.pm * 256;
        const float l2g = __log2f(1.0f - exp2f(-5.0f - (float)u.pn));
        int r0 = wr * 64 + fr, c0 = wc * 32 + 8 * fq; asm volatile("" : "+v"(r0), "+v"(c0));
#pragma unroll
        for (int ai = 0; ai < 2; ++ai)
#pragma unroll
            for (int m = 0; m < 4; ++m) { const int r = r0 + ai * 128 + m * 16; bf16_t* rowp = tile + (size_t)r * 2048 + c0;
                const float* rt = rot + ((size_t)(tok0 + u.pm * 256 + r) * 128 + (c0 >> 1)) * 2;
                const float dk = __builtin_amdgcn_exp2f((float)(255 - r) * l2g);
#pragma unroll
                for (int bj = 0; bj < 2; ++bj) { const f32x4 cs0 = *(const f32x4*)(rt + bj * 128), cs1 = *(const f32x4*)(rt + bj * 128 + 4);
                    const f32x4 v0 = acc[ai][bj][m][0], v1 = acc[ai][bj][m][1]; float o[8];
                    o[0] = (v0[0] * cs0[0] - v0[1] * cs0[1]) * scale; o[1] = (v0[1] * cs0[0] + v0[0] * cs0[1]) * scale;
                    o[2] = (v0[2] * cs0[2] - v0[3] * cs0[3]) * scale; o[3] = (v0[3] * cs0[2] + v0[2] * cs0[3]) * scale;
                    o[4] = (v1[0] * cs1[0] - v1[1] * cs1[1]) * scale; o[5] = (v1[1] * cs1[0] + v1[0] * cs1[1]) * scale;
                    o[6] = (v1[2] * cs1[2] - v1[3] * cs1[3]) * scale; o[7] = (v1[3] * cs1[2] + v1[2] * cs1[3]) * scale;
                    *(u32x4*)(rowp + bj * 128) = pack8(o);
                    bf16_t* tp = ttile + (size_t)(c0 + bj * 128) * 16384 + r;
#pragma unroll
                    for (int j = 0; j < 8; ++j) tp[(size_t)j * 16384] = (bf16_t)f2bf(o[j] * dk); } }
    }
};

__device__ __forceinline__ int xcd_unit(int i, int G, int c) { return ((G & 7) == 0) ? i * G + (c & 7) * (G >> 3) + (c >> 3) : i * G + c; }
struct GateSched {
    static constexpr bool GATHER = false;
    const char* A; const char* B; int G, c; static constexpr int lda = 1024, ldb = 256, K = 256;
    __device__ __forceinline__ bool next(int i, pg8::Unit& u) const {
        const int L = xcd_unit(i, G, c); if (L >= 128 * 8) return false;
        const int pm = L >> 3, j = (L >> 1) & 3, pn = L & 1;
        u.pm = pm; u.pn = j * 2 + pn; u.x0 = 0; u.x1 = 0; u.a = A + ((size_t)pm * 256 * 1024 + j * 256) * 2; u.b = B + ((size_t)(j * 512 + pn * 256) * 256) * 2; return true;
    }
    __device__ __forceinline__ unsigned row_off(const pg8::Unit&, int) const { return 0u; }
};
struct Moe1Sched {
    static constexpr bool GATHER = true;
    const char* A; const char* B; const int* rowtok; const LAS int* tt; int G, c; static constexpr int lda = 2048, ldb = 2048, K = 2048;
    __device__ __forceinline__ bool next(int i, pg8::Unit& u) const {
        const int L = xcd_unit(i, G, c); if (L >= tt[0] * 4) return false;
        const int rt = L >> 2, pn = L & 3, e = tt[1 + rt];
        u.pm = rt; u.pn = pn; u.x0 = e; u.x1 = 0; u.a = A; u.b = B + ((size_t)(e * 1024 + pn * 256) * 2048) * 2; return true;
    }
    __device__ __forceinline__ unsigned row_off(const pg8::Unit& u, int r) const { return (unsigned)rowtok[u.pm * 256 + r] * (unsigned)(2048 * 2); }
};
struct Moe2Sched {
    static constexpr bool GATHER = false;
    const char* A; const char* B; const LAS int* tt; int G, c; static constexpr int lda = 512, ldb = 512, K = 512;
    __device__ __forceinline__ bool next(int i, pg8::Unit& u) const {
        const int L = xcd_unit(i, G, c); if (L >= tt[0] * 8) return false;
        const int rt = L >> 3, pn = L & 7, e = tt[1 + rt];
        u.pm = rt; u.pn = pn; u.x0 = e; u.x1 = 0; u.a = A + (size_t)rt * 256 * 512 * 2; u.b = B + ((size_t)(e * 2048 + pn * 256) * 512) * 2; return true;
    }
    __device__ __forceinline__ unsigned row_off(const pg8::Unit&, int) const { return 0u; }
};
struct SpSched {
    static constexpr bool GATHER = false;
    const char* qcat; const char* kb; int G, c; static constexpr int lda = 512, ldb = 2048, K = 256;
    __device__ __forceinline__ bool next(int i, pg8::Unit& u) const {
        const int L = xcd_unit(i, G, c); if (L >= 512) return false;
        const int h = L >> 6, n = L & 63;
        u.pm = n; u.pn = 0; u.x0 = h; u.x1 = 0; u.a = qcat + (((size_t)h * 16384 + (size_t)n * 256) * 512 + 256) * 2; u.b = kb + ((size_t)n * 256 * 2048 + h * 256) * 2; return true;
    }
    __device__ __forceinline__ unsigned row_off(const pg8::Unit&, int) const { return 0u; }
};
struct KvSched {
    static constexpr bool GATHER = false;
    const char* vr; const char* kdt; int G, c; static constexpr int lda = 512, ldb = 16384, K = 256;
    __device__ __forceinline__ bool next(int i, pg8::Unit& u) const {
        const int L = xcd_unit(i, G, c); if (L >= 1024) return false;
        const int hn = L >> 1, pe = L & 1, h = hn >> 6, n = hn & 63;
        const size_t o = ((size_t)hn * 512 + pe * 256) * 512;
        u.pm = 0; u.pn = 0; u.x0 = (int)(unsigned)((o + 256) & 0xffffffffu); u.x1 = (int)(unsigned)((o + 256) >> 32);
        u.a = vr + o * 2; u.b = kdt + ((size_t)h * 256 * 16384 + (size_t)n * 256) * 2; return true;
    }
    __device__ __forceinline__ unsigned row_off(const pg8::Unit&, int) const { return 0u; }
};
struct YSched {
    static constexpr bool GATHER = false;
    const char* qcat; const char* vr; int G, c; static constexpr int lda = 512, ldb = 512, K = 512;
    __device__ __forceinline__ bool next(int i, pg8::Unit& u) const {
        const int L = xcd_unit(i, G, c); if (L >= 1024) return false;
        const int hn = L >> 1, pn = L & 1, h = hn >> 6, n = hn & 63;
        u.pm = n; u.pn = pn; u.x0 = h; u.x1 = 0; u.a = qcat + (((size_t)h * 16384 + (size_t)n * 256) * 512) * 2; u.b = vr + (((size_t)hn * 512 + pn * 256) * 512) * 2; return true;
    }
    __device__ __forceinline__ unsigned row_off(const pg8::Unit&, int) const { return 0u; }
};
struct VtSched {
    static constexpr bool GATHER = false;
    const char* w; const char* hb; int G, c; static constexpr int lda = 2048, ldb = 2048, K = 2048;
    __device__ __forceinline__ bool next(int i, pg8::Unit& u) const {
        const int L = i * G + c; if (L >= 1024) return false;
        int pmE, n; pg8::tile_order(L, 16, 64, pmE, n);
        const int h = pmE >> 1;
        const size_t o = (((size_t)(h * 64 + n)) * 512 + (pmE & 1) * 256) * 512;
        u.pm = pmE; u.pn = n; u.x0 = (int)(unsigned)(o & 0xffffffffu); u.x1 = (int)(unsigned)(o >> 32);
        u.a = w + (size_t)pmE * 256 * 2048 * 2; u.b = hb + (size_t)n * 256 * 2048 * 2; return true;
    }
    __device__ __forceinline__ unsigned row_off(const pg8::Unit&, int) const { return 0u; }
};

struct Args { const void* in[25]; float* out; unsigned char* ws; int ph_lo, ph_hi; int li, pad; };

struct Frame {
    LAS unsigned char* lds; int tid, lane, wave, G, bid;
};

struct RmIdent { __device__ __forceinline__ int operator()(int n) const { return n; } };
struct RmOdIn { __device__ __forceinline__ int operator()(int n) const { if (n >= 4096) return n; const int r = n & 255; return (n & ~255) + (r < 128 ? 2 * r : 2 * (r - 128) + 1); } };
struct RmGU { int add; __device__ __forceinline__ int operator()(int n) const { return (n >> 7) * 256 + (n & 127) + add; } };
template <class RM>
__device__ __forceinline__ void transpose_item(const float* W, int K, int N, bf16_t* WT, const RM rm, LAS float* scr, int item, int lane) {
    const int nblk = N / 32, kb = item / nblk, nb = item % nblk, k0 = 64 * kb, n0 = 32 * nb;
#pragma unroll 8
    for (int i = 0; i < 32; ++i) { const int kk = 2 * i + (lane >> 5); scr[kk * 33 + (lane & 31)] = W[(size_t)(k0 + kk) * N + n0 + (lane & 31)]; }
    LDS_WAIT(); asm volatile("" ::: "memory");
    const int c = lane & 7;
#pragma unroll
    for (int j = 0; j < 4; ++j) { const int n = (lane >> 3) + 8 * j; const LAS float* s = scr + (8 * c) * 33 + n;
        u32x4 o; o.x = pk2(s[0 * 33], s[1 * 33]); o.y = pk2(s[2 * 33], s[3 * 33]); o.z = pk2(s[4 * 33], s[5 * 33]); o.w = pk2(s[6 * 33], s[7 * 33]);
        *(u32x4*)(WT + (size_t)rm(n0 + n) * K + k0 + 8 * c) = o; }
    LDS_WAIT(); asm volatile("" ::: "memory");
}
__device__ __forceinline__ void convert_experts(const Frame& F, const float* wg, const float* wu, const float* wd, unsigned char* ws) {
    LAS float* scr = (LAS float*)(F.lds + F.wave * 16384);
    const int gw = F.bid * 8 + F.wave, NGW = F.G * 8;
    bf16_t* gu = (bf16_t*)(ws + WS_WGU); bf16_t* dd = (bf16_t*)(ws + WS_WD);
    for (int it = gw; it < 3 * 16384; it += NGW) {
        const int which = it >> 14, r = it & 16383, e = r >> 9, ii = r & 511;
        if (which == 0) transpose_item(wg + (size_t)e * 2048 * 512, 2048, 512, gu + (size_t)e * 1024 * 2048, RmGU{0}, scr, ii, F.lane);
        else if (which == 1) transpose_item(wu + (size_t)e * 2048 * 512, 2048, 512, gu + (size_t)e * 1024 * 2048, RmGU{128}, scr, ii, F.lane);
        else transpose_item(wd + (size_t)e * 512 * 2048, 512, 2048, dd + (size_t)e * 2048 * 512, RmIdent{}, scr, ii, F.lane);
    }
}
__device__ __forceinline__ void rms_row_to_bf16(const float* xrow, const float* gain, bf16_t* orow, int lane) {
    const f32x4* xr = (const f32x4*)xrow + lane; const f32x4* gr = (const f32x4*)gain + lane;
    f32x4 v[8]; float s = 0.f;
#pragma unroll
    for (int j = 0; j < 8; ++j) { v[j] = xr[64 * j]; s += (v[j].x * v[j].x + v[j].y * v[j].y) + (v[j].z * v[j].z + v[j].w * v[j].w); }
    const float rstd = 1.0f / sqrtf(wave_sum(s) * (1.0f / D) + EPS);
    u32x2* o8 = (u32x2*)orow + lane;
#pragma unroll
    for (int j = 0; j < 8; ++j) { const f32x4 g = gr[64 * j]; u32x2 w; w.x = pk2(v[j].x * rstd * g.x, v[j].y * rstd * g.y); w.y = pk2(v[j].z * rstd * g.z, v[j].w * rstd * g.w); o8[64 * j] = w; }
}

typedef const __attribute__((address_space(4))) Args* ArgP;
__device__ __forceinline__ ArgP launder(ArgP p) { asm volatile("" : "+s"(p)); return p; }
#define INP(T_, k) ((const T_*)ap->in[k])
__device__ __forceinline__ Frame relaunder(const Frame& f) { Frame g = f; asm volatile("" : "+v"(g.tid)); g.lane = g.tid & 63; g.wave = __builtin_amdgcn_readfirstlane(g.tid >> 6); return g; }

__device__ __forceinline__ void ph_prologue(ArgP ap, const Frame& F_) {
    ap = launder(ap); unsigned char* ws = ap->ws; const Frame F = relaunder(F_);
    const int gw = F.bid * 8 + F.wave, NGW = F.G * 8, gt = F.bid * 512 + F.tid, NGT = F.G * 512;
    LAS float* scr = (LAS float*)(F.lds + F.wave * 16384);
    constexpr int I_A = 32 * 160, I_B = 32 * 64, I_C = 32 * 384, I_D = 64 * 64;
    for (int it = gw; it < I_A + I_B + I_C + I_D; it += NGW) {
        int r = it;
        if (r < I_A) { transpose_item(INP(float, 3), 2048, EV_IN, (bf16_t*)(ws + WS_WEVI), RmIdent{}, scr, r, F.lane); continue; } r -= I_A;
        if (r < I_B) { transpose_item(INP(float, 11), 2048, 2048, (bf16_t*)(ws + WS_WEVO), RmIdent{}, scr, r, F.lane); continue; } r -= I_B;
        if (r < I_C) { transpose_item(INP(float, 13), 2048, OD_IN, (bf16_t*)(ws + WS_WOD), RmOdIn{}, scr, r, F.lane); continue; } r -= I_C;
        transpose_item(INP(float, 15), 4096, 2048, (bf16_t*)(ws + WS_WODO), RmIdent{}, scr, r, F.lane);
    }
    convert_experts(F, INP(float, 21), INP(float, 22), INP(float, 23), ws);
    { bf16_t* wgp = (bf16_t*)(ws + WS_WGATE); const float* ga = INP(float, 6); const float* gx = INP(float, 8);
      for (int idx = gt; idx < 4 * 512 * 256; idx += NGT) { const int j = idx >> 17, o = (idx >> 8) & 511, kk = idx & 255, pn = o >> 8, bx = (o >> 7) & 1, ch = o & 127, g = 2 * j + pn, gk = 2 * j + (kk >> 7), i = kk & 127;
          const float v = (gk == g) ? (bx ? gx : ga)[(g * 128 + i) * 128 + ch] : 0.f; wgp[idx] = (bf16_t)f2bf(v); } }
    { float* rot = (float*)(ws + WS_ROT); const int* positions = INP(int, 1);
      for (int idx = gt; idx < T * 128; idx += NGT) { const int t = idx >> 7, i = idx & 127;
          const float inv = exp2f(-(float)i * (13.287712379549449f / 128.0f)); const float ang = (float)positions[t] * inv;
          const float k = rintf(ang * 0.15915494309189535f); float r = fmaf(-k, 6.28125f, ang); r = fmaf(-k, 1.9353071795864769e-3f, r);
          f32x2 cs; cs.x = __cosf(r); cs.y = __sinf(r); *(f32x2*)(rot + (size_t)idx * 2) = cs; } }
    { const float* x_in = INP(float, 0); const float* g = INP(float, 2); bf16_t* Hb = (bf16_t*)(ws + WS_H);
      for (int m = gw; m < T; m += NGW) rms_row_to_bf16(x_in + (size_t)m * D, g, Hb + (size_t)m * D, F.lane); }
}
__device__ __forceinline__ void ph_inproj0(ArgP ap, const Frame& F_) {
    ap = launder(ap); unsigned char* ws = ap->ws; const Frame F = relaunder(F_);
    pg8::DenseSched<128, 20, 2048, 2048, 2048> S{(const char*)(ws + WS_H), (const char*)(ws + WS_WEVI), F.G, F.bid};
    EpiPlain E{(bf16_t*)(ws + WS_PROJ0), EV_IN, (size_t)256 * EV_IN, 256};
    pg8::gemm_phase(F.lds, S, E);
}
__device__ __forceinline__ void ph_conv_attn(ArgP ap, const Frame& F_) {
    ap = launder(ap); unsigned char* ws = ap->ws; const Frame F = relaunder(F_);
    const int gt = F.bid * 512 + F.tid, NGT = F.G * 512;
    const bf16_t* proj = (const bf16_t*)(ws + WS_PROJ0);
    { bf16_t* xc = (bf16_t*)(ws + WS_XC); const float* cw = INP(float, 4); const float* cb = INP(float, 5);
      const int c8 = (gt & 127) * 8; float wk[4][8], bb[8];
#pragma unroll
      for (int j = 0; j < 8; ++j) { bb[j] = cb[c8 + j];
#pragma unroll
          for (int k = 0; k < 4; ++k) wk[k][j] = cw[k * 1024 + c8 + j]; }
      for (int t = gt >> 7; t < T; t += NGT >> 7) { const int s = t & (SEQ - 1);
          float a[8];
#pragma unroll
          for (int j = 0; j < 8; ++j) a[j] = bb[j];
#pragma unroll
          for (int k = 0; k < 4; ++k) { if (s - 3 + k >= 0) { const u32x4 w = *(const u32x4*)(proj + (size_t)(t - 3 + k) * EV_IN + c8); float f[8]; unpack8(w, f);
#pragma unroll
                  for (int j = 0; j < 8; ++j) a[j] = fmaf(wk[k][j], f[j], a[j]); } }
          *(u32x4*)(xc + (size_t)t * 1024 + c8) = pack8(a); } }
    LAS unsigned char* L = F.lds;
    LAS bf16_t* Qs = (LAS bf16_t*)(L);
    LAS bf16_t* Os = (LAS bf16_t*)(L);
    volatile LAS unsigned* flag = (volatile LAS unsigned*)(L + 104448);
    bf16_t* y0 = (bf16_t*)(ws + WS_Y0);
    const int w = F.wave, l = F.lane, l15 = l & 15, l4 = l >> 4;
    const float scale = 0.08838834764831845f;
    typedef short s16x4 __attribute__((ext_vector_type(4)));
#define ATT_TR4(r0, r1, r2, r3, base, o0, o1, o2, o3) asm volatile("ds_read_b64_tr_b16 %0, %4 offset:%5\n\tds_read_b64_tr_b16 %1, %4 offset:%6\n\tds_read_b64_tr_b16 %2, %4 offset:%7\n\tds_read_b64_tr_b16 %3, %4 offset:%8\n\ts_waitcnt lgkmcnt(0)" \
        : "=&v"(r0), "=&v"(r1), "=&v"(r2), "=&v"(r3) : "v"(base), "i"(o0), "i"(o1), "i"(o2), "i"(o3) : "memory")
    for (int u = F.bid; u < 2048; u += F.G) {
        const int b = u >> 10, h = (u >> 7) & 7, qt = u & 127; const int t0 = b * SEQ + qt * 128;
        u32x4 kr[2], vr[2];
#define ATT_LOADKV(kb_) do { const int k0_ = b * SEQ + (kb_) * 64; _Pragma("unroll") for (int i = 0; i < 2; ++i) { const int id = F.tid + 512 * i; \
            kr[i] = *(const u32x4*)(proj + (size_t)(k0_ + (id >> 4)) * EV_IN + 3072 + h * 128 + (id & 15) * 8); \
            vr[i] = *(const u32x4*)(proj + (size_t)(k0_ + (id >> 4)) * EV_IN + 4096 + h * 128 + (id & 15) * 8); } } while (0)
#define ATT_STOREKV(buf_) do { _Pragma("unroll") for (int i = 0; i < 2; ++i) { const int id = F.tid + 512 * i; \
            *(LAS u32x4*)(L + 34816 + (buf_) * 17408 + ((id >> 4) * 136 + (id & 15) * 8) * 2) = kr[i]; \
            *(LAS u32x4*)(L + 69632 + (buf_) * 17408 + ((id >> 4) * 136 + (id & 15) * 8) * 2) = vr[i]; } } while (0)
        __syncthreads();
        for (int i = 0; i < 4; ++i) { const int id = F.tid + 512 * i, row = id >> 4, ch = id & 15;
            *(LAS u32x4*)(Qs + row * 136 + ch * 8) = *(const u32x4*)(proj + (size_t)(t0 + row) * EV_IN + 2048 + h * 128 + ch * 8); }
        ATT_LOADKV(2 * qt + 1);
        ATT_STOREKV(0);
        if (F.tid == 0) flag[0] = 0u;
        __syncthreads();
        bf16x8 qf[4];
#pragma unroll
        for (int ks = 0; ks < 4; ++ks) qf[ks] = *(const LAS bf16x8*)(Qs + (16 * w + l15) * 136 + 32 * ks + 8 * l4);
        f32x4 o[8];
#pragma unroll
        for (int dt = 0; dt < 8; ++dt) o[dt] = (f32x4){0.f, 0.f, 0.f, 0.f};
        float carry = 0.f;
        const int qs = qt * 128 + 16 * w + l15;
        int cur = 0, it = 0;
        for (int kb = 2 * qt + 1; kb >= 0; --kb) {
            if (kb > 0) ATT_LOADKV(kb - 1);
            const LAS bf16_t* Kc = (const LAS bf16_t*)(L + 34816 + cur * 17408);
            f32x4 st[4];
#pragma unroll
            for (int kt = 0; kt < 4; ++kt) { st[kt] = (f32x4){0.f, 0.f, 0.f, 0.f};
#pragma unroll
                for (int ks = 0; ks < 4; ++ks) { const bf16x8 kf = *(const LAS bf16x8*)(Kc + (16 * kt + l15) * 136 + 32 * ks + 8 * l4);
                    st[kt] = __builtin_amdgcn_mfma_f32_16x16x32_bf16(kf, qf[ks], st[kt], 0, 0, 0); } }
            float m1[4][4], tot[4], suf[4];
#pragma unroll
            for (int kt = 0; kt < 4; ++kt) { float g = 0.f;
#pragma unroll
                for (int rg = 0; rg < 4; ++rg) { const float z = st[kt][rg] * scale; st[kt][rg] = z; const bool ok = (kb * 64 + 16 * kt + 4 * l4 + rg) < qs;
                    const float sp_ = fmaxf(z, 0.f) + __logf(1.0f + __expf(-fabsf(z)));
                    m1[kt][rg] = ok ? -sp_ : 0.f; g += m1[kt][rg]; }
                const float a = __shfl_xor(g, 16); const float ps = g + a; const float b2 = __shfl_xor(ps, 32);
                tot[kt] = ps + b2; suf[kt] = ((l4 & 1) == 0 ? a : 0.f) + ((l4 & 2) == 0 ? b2 : 0.f); }
            float pw[4][4]; float running = carry;
#pragma unroll
            for (int kt = 3; kt >= 0; --kt) { float base = running + suf[kt];
#pragma unroll
                for (int rg = 3; rg >= 0; --rg) { const bool ok = (kb * 64 + 16 * kt + 4 * l4 + rg) < qs;
                    pw[kt][rg] = ok ? __expf(m1[kt][rg] + st[kt][rg] + base) : 0.f; base += m1[kt][rg]; }
                running += tot[kt]; }
            carry = running;
            const unsigned vb = (unsigned)(size_t)(L + 69632 + cur * 17408) + (unsigned)(((4 * l4 + (l15 >> 2)) * 136 + 4 * (l15 & 3)) * 2);
#pragma unroll
            for (int a2 = 0; a2 < 2; ++a2) {
                bf16x8 pf; { const unsigned p0 = pk2(pw[2 * a2][0], pw[2 * a2][1]), p1 = pk2(pw[2 * a2][2], pw[2 * a2][3]), p2 = pk2(pw[2 * a2 + 1][0], pw[2 * a2 + 1][1]), p3 = pk2(pw[2 * a2 + 1][2], pw[2 * a2 + 1][3]);
                    const u32x4 pp = {p0, p1, p2, p3}; pf = __builtin_bit_cast(bf16x8, pp); }
#pragma unroll
                for (int dp = 0; dp < 4; ++dp) { s16x4 v0, v1, v2, v3;
                    if (a2 == 0) ATT_TR4(v0, v1, v2, v3, vb, (2 * dp) * 32, (2 * dp) * 32 + 4352, (2 * dp + 1) * 32, (2 * dp + 1) * 32 + 4352);
                    else ATT_TR4(v0, v1, v2, v3, vb, 8704 + (2 * dp) * 32, 8704 + (2 * dp) * 32 + 4352, 8704 + (2 * dp + 1) * 32, 8704 + (2 * dp + 1) * 32 + 4352);
                    const bf16x8 vf0 = __builtin_shufflevector(v0, v1, 0, 1, 2, 3, 4, 5, 6, 7), vf1 = __builtin_shufflevector(v2, v3, 0, 1, 2, 3, 4, 5, 6, 7);
                    o[2 * dp] = __builtin_amdgcn_mfma_f32_16x16x32_bf16(pf, vf0, o[2 * dp], 0, 0, 0);
                    o[2 * dp + 1] = __builtin_amdgcn_mfma_f32_16x16x32_bf16(pf, vf1, o[2 * dp + 1], 0, 0, 0); } }
            if (__any(carry > -104.0f)) { if (l == 0) flag[0] = (unsigned)(it + 1); }
            if (kb > 0) ATT_STOREKV(cur ^ 1);
            __syncthreads();
            if (flag[0] < (unsigned)(it + 1)) break;
            cur ^= 1; ++it;
        }
#undef ATT_LOADKV
#undef ATT_STOREKV
        __syncthreads();
#pragma unroll
        for (int dt = 0; dt < 8; ++dt)
#pragma unroll
            for (int rg = 0; rg < 4; ++rg) Os[(16 * w + 4 * l4 + rg) * 136 + 16 * dt + l15] = (bf16_t)f2bf(o[dt][rg]);
        __syncthreads();
        for (int i = 0; i < 4; ++i) { const int id = F.tid + 512 * i, row = id >> 4, ch = id & 15;
            *(u32x4*)(y0 + (size_t)(t0 + row) * 2048 + 1024 + h * 128 + ch * 8) = *(const LAS u32x4*)(Os + row * 136 + ch * 8); }
    }
#undef ATT_TR4
    __syncthreads();
}
__device__ __forceinline__ void ph_gates(ArgP ap, const Frame& F_) {
    ap = launder(ap); unsigned char* ws = ap->ws; const Frame F = relaunder(F_);
    GateSched S{(const char*)(ws + WS_XC), (const char*)(ws + WS_WGATE), F.G, F.bid};
    EpiPlain E{(bf16_t*)(ws + WS_GPRE), 2048, (size_t)256 * 2048, 256};
    pg8::gemm_phase(F.lds, S, E);
}
__device__ __forceinline__ void ph_scan(ArgP ap, const Frame& F_, const int pass) {
    ap = launder(ap); unsigned char* ws = ap->ws; const Frame F = relaunder(F_);
    const bf16_t* gpre = (const bf16_t*)(ws + WS_GPRE); const bf16_t* xc = (const bf16_t*)(ws + WS_XC); const bf16_t* proj = (const bf16_t*)(ws + WS_PROJ0);
    f32x2* SUB = (f32x2*)(ws + WS_SUB); f32x2* CH = (f32x2*)(ws + WS_CH); bf16_t* y0 = (bf16_t*)(ws + WS_Y0);
    LAS f32x2* Ls = (LAS f32x2*)F.lds;
    const int cg = F.tid & 127, sub = F.tid >> 7, ch0 = cg * 8, g = ch0 >> 7, chin = ch0 & 127;
    float ba[8], bx[8], spl[8];
    { const float* gab = INP(float, 7); const float* gxb = INP(float, 9); const float* lamp = INP(float, 10);
#pragma unroll
      for (int j = 0; j < 8; ++j) { ba[j] = gab[ch0 + j]; bx[j] = gxb[ch0 + j]; const float lam = lamp[ch0 + j]; spl[j] = fmaxf(-lam, 0.f) + log1pf(__expf(-fabsf(lam))); } }
    for (int u = F.bid; u < 256; u += F.G) {
        const int b = u >> 7, c = u & 127;
        float hst[8], Ast[8];
#pragma unroll
        for (int j = 0; j < 8; ++j) { hst[j] = 0.f; Ast[j] = 1.f; }
        __syncthreads();
        if (pass == 1) {
            { const int c2 = F.tid * 2; float h0 = 0.f, h1 = 0.f;
              for (int cc = 0; cc < c; ++cc) { const f32x4 s = *(const f32x4*)(CH + ((size_t)(b * 128 + cc) * 1024 + c2)); h0 = fmaf(s.x, h0, s.y); h1 = fmaf(s.z, h1, s.w); }
              ((LAS float*)Ls)[c2] = h0; ((LAS float*)Ls)[c2 + 1] = h1; }
            __syncthreads();
#pragma unroll
            for (int j = 0; j < 8; ++j) hst[j] = ((LAS float*)Ls)[ch0 + j];
            for (int s2 = 0; s2 < sub; ++s2) { const f32x2* sp2 = SUB + ((size_t)(b * 512 + c * 4 + s2) * 1024 + ch0);
#pragma unroll
                for (int j = 0; j < 8; ++j) { const f32x2 s = sp2[j]; hst[j] = fmaf(s.x, hst[j], s.y); } }
        }
        const int tbase = b * SEQ + c * 128 + sub * 32;
        for (int i0 = 0; i0 < 32; i0 += 4) {
            u32x4 rpa[4], rpx[4], rxv[4], rgr[4];
#pragma unroll
            for (int ii = 0; ii < 4; ++ii) { const size_t t = (size_t)(tbase + i0 + ii);
                rpa[ii] = *(const u32x4*)(gpre + t * 2048 + g * 256 + chin); rpx[ii] = *(const u32x4*)(gpre + t * 2048 + g * 256 + 128 + chin); rxv[ii] = *(const u32x4*)(xc + t * 1024 + ch0);
                if (pass == 1) rgr[ii] = *(const u32x4*)(proj + t * EV_IN + 1024 + ch0); }
#pragma unroll
            for (int ii = 0; ii < 4; ++ii) { const size_t t = (size_t)(tbase + i0 + ii);
                float pa[8], px[8], xv[8], gr[8], outv[8];
                unpack8(rpa[ii], pa); unpack8(rpx[ii], px); unpack8(rxv[ii], xv);
                if (pass == 1) unpack8(rgr[ii], gr);
#pragma unroll
                for (int j = 0; j < 8; ++j) {
                    const float r = sigmoidf_(pa[j] + ba[j]), ig = sigmoidf_(px[j] + bx[j]);
                    const float la = -8.0f * r * spl[j]; const float a = __expf(la);
                    const float mlt = __builtin_amdgcn_sqrtf(fmaxf(1.0f - a * a, 0.f));
                    const float uu = mlt * (ig * xv[j]);
                    hst[j] = fmaf(a, hst[j], uu); Ast[j] *= a;
                    if (pass == 1) outv[j] = hst[j] * gelu_tanh(gr[j]);
                }
                if (pass == 1) *(u32x4*)(y0 + t * 2048 + ch0) = pack8(outv);
            }
        }
        if (pass == 0) {
            f32x2* sp2 = SUB + ((size_t)(b * 512 + c * 4 + sub) * 1024 + ch0);
#pragma unroll
            for (int j = 0; j < 8; ++j) { f32x2 s; s.x = Ast[j]; s.y = hst[j]; sp2[j] = s; Ls[sub * 1024 + ch0 + j] = s; }
            __syncthreads();
            if (sub == 0) {
#pragma unroll
                for (int j = 0; j < 8; ++j) { float A = 1.f, Hh = 0.f;
#pragma unroll
                    for (int s2 = 0; s2 < 4; ++s2) { const f32x2 s = Ls[s2 * 1024 + ch0 + j]; Hh = fmaf(s.x, Hh, s.y); A *= s.x; }
                    f32x2 o; o.x = A; o.y = Hh; CH[(size_t)(b * 128 + c) * 1024 + ch0 + j] = o; }
            }
        }
    }
    __syncthreads();
}
__device__ __forceinline__ void ph_outproj0(ArgP ap, const Frame& F_) {
    ap = launder(ap); unsigned char* ws = ap->ws; const Frame F = relaunder(F_);
    pg8::DenseSched<128, 8, 2048, 2048, 2048> S{(const char*)(ws + WS_Y0), (const char*)(ws + WS_WEVO), F.G, F.bid};
    EpiResid E{INP(float, 0), ap->out, 0};
    pg8::gemm_phase(F.lds, S, E);
}
__device__ __forceinline__ void ph_l1_inproj(ArgP ap, const Frame& F_, const int b) {
    ap = launder(ap); unsigned char* ws = ap->ws; const Frame F = relaunder(F_);
    const char* Hbb = (const char*)(ws + WS_H) + (size_t)b * SEQ * D * 2; const char* wod = (const char*)(ws + WS_WOD); const float* rot = (const float*)(ws + WS_ROT);
    { pg8::DenseSched<64, 8, 2048, 2048, 2048> S{Hbb, wod, F.G, F.bid};
      EpiRotary E{(bf16_t*)(ws + WS_QCAT) + 256, 512, (size_t)256 * 512, (size_t)16384 * 512, rot, b * SEQ, 1.0f};
      pg8::gemm_phase(F.lds, S, E); }
    { pg8::DenseSched<64, 8, 2048, 2048, 2048> S{Hbb, wod + (size_t)2048 * 2048 * 2, F.G, F.bid};
      EpiRotaryT E{(bf16_t*)(ws + WS_KB), (bf16_t*)(ws + WS_KDT), rot, b * SEQ, 0.0625f};
      pg8::gemm_phase(F.lds, S, E); }
    { VtSched S{wod + (size_t)4096 * 2048 * 2, Hbb, F.G, F.bid};
      EpiUnitPtr E{(bf16_t*)(ws + WS_VRCAT), 512};
      pg8::gemm_phase(F.lds, S, E); }
}
__device__ __forceinline__ void ph_l1_kv(ArgP ap, const Frame& F_) {
    ap = launder(ap); unsigned char* ws = ap->ws; const Frame F = relaunder(F_);
    KvSched S{(const char*)(ws + WS_VRCAT), (const char*)(ws + WS_KDT), F.G, F.bid};
    EpiUnitPtr E{(bf16_t*)(ws + WS_VRCAT), 512};
    pg8::gemm_phase(F.lds, S, E);
}
__device__ __forceinline__ void ph_l1_rscan(ArgP ap, const Frame& F_) {
    ap = launder(ap); unsigned char* ws = ap->ws; const Frame F = relaunder(F_);
    bf16_t* vrcat = (bf16_t*)(ws + WS_VRCAT);
    for (int v = F.bid * 512 + F.tid; v < 131072; v += F.G * 512) {
        const int h = v >> 14, rem = v & 16383, e = rem >> 5, d8 = rem & 31;
        const float cd = __builtin_amdgcn_exp2f(256.0f * __log2f(1.0f - exp2f(-5.0f - (float)h)));
        bf16_t* p = vrcat + ((size_t)h * 64 * 512 + e) * 512 + 256 + d8 * 8;
        float R[8];
#pragma unroll
        for (int j = 0; j < 8; ++j) R[j] = 0.f;
        for (int n0 = 0; n0 < 64; n0 += 8) {
            u32x4 raw[8];
#pragma unroll
            for (int j2 = 0; j2 < 8; ++j2) raw[j2] = *(const u32x4*)(p + (size_t)(n0 + j2) * 512 * 512);
#pragma unroll
            for (int j2 = 0; j2 < 8; ++j2) { float kv[8]; unpack8(raw[j2], kv);
                *(u32x4*)(p + (size_t)(n0 + j2) * 512 * 512) = pack8(R);
#pragma unroll
                for (int j = 0; j < 8; ++j) R[j] = fmaf(cd, R[j], kv[j]); }
        }
    }
    { bf16_t* qcat = (bf16_t*)(ws + WS_QCAT);
      SpSched S{(const char*)qcat, (const char*)(ws + WS_KB), F.G, F.bid};
      EpiSprime E{qcat};
      pg8::gemm_phase(F.lds, S, E); }
}
__device__ __forceinline__ void ph_l1_y(ArgP ap, const Frame& F_) {
    ap = launder(ap); unsigned char* ws = ap->ws; const Frame F = relaunder(F_);
    YSched S{(const char*)(ws + WS_QCAT), (const char*)(ws + WS_VRCAT), F.G, F.bid};
    EpiY E{(bf16_t*)(ws + WS_YB), (f32x2*)(ws + WS_STATS)};
    pg8::gemm_phase(F.lds, S, E);
}
__device__ __forceinline__ void ph_l1_gnorm(ArgP ap, const Frame& F_, const int b) {
    ap = launder(ap); unsigned char* ws = ap->ws; const Frame F = relaunder(F_);
    const char* Hbb = (const char*)(ws + WS_H) + (size_t)b * SEQ * D * 2; const char* wod = (const char*)(ws + WS_WOD);
    pg8::DenseSched<64, 16, 2048, 2048, 2048> S{Hbb, wod + (size_t)8192 * 2048 * 2, F.G, F.bid};
    EpiGnorm E{(bf16_t*)(ws + WS_YB), (const f32x2*)(ws + WS_STATS), INP(float, 14)};
    pg8::gemm_phase(F.lds, S, E);
}
__device__ __forceinline__ void ph_l1_out(ArgP ap, const Frame& F_, const int b) {
    ap = launder(ap); unsigned char* ws = ap->ws; const Frame F = relaunder(F_);
    pg8::DenseSched<64, 8, 4096, 4096, 4096> S{(const char*)(ws + WS_YB), (const char*)(ws + WS_WODO), F.G, F.bid};
    EpiResid E{ap->out, ap->out, b * SEQ};
    pg8::gemm_phase(F.lds, S, E);
}
typedef float f32x16 __attribute__((ext_vector_type(16)));
__device__ __forceinline__ void ph_router(ArgP ap, const Frame& F_, const int layer) {
    ap = launder(ap); unsigned char* ws = ap->ws; const Frame F = relaunder(F_);
    if (layer == 1) convert_experts(F, INP(float, 21) + (size_t)32 * 2048 * 512, INP(float, 22) + (size_t)32 * 2048 * 512, INP(float, 23) + (size_t)32 * 512 * 2048, ws);
    const float* xres = ap->out; bf16_t* Hb = (bf16_t*)(ws + WS_H);
    int* CNT = (int*)(ws + SM_CNT); int* ASGE = (int*)(ws + SM_ASGE); int* ASGR = (int*)(ws + SM_ASGR); float* ASGW = (float*)(ws + SM_ASGW);
    const float* gain = INP(float, 16) + layer * D; const float* wgp = INP(float, 17) + (size_t)layer * D * 4; const float* wep = INP(float, 19) + (size_t)layer * D * 32;
    const float* bgp = INP(float, 18) + layer * 4; const float* bep = INP(float, 20) + layer * 32;
    LAS float* xs = (LAS float*)F.lds;
    LAS float* wc = xs + 128 * 65;
    LAS float* pe = wc + 64 * 40;
    LAS float* pg = pe + 2 * 128 * 33;
    LAS float* lg = pg + 4 * 128 * 5;
    LAS float* rs = lg + 128 * 36;
    LAS int* el = (LAS int*)(rs + 128);
    LAS int* wcnt = el + 256;
    const int w = F.wave, l = F.lane, mt = w & 3, kh = w >> 2, l31 = l & 31, l5 = l >> 5;
    const int tl = F.tid & 127, kq = F.tid >> 7;
    for (int tile = F.bid; tile < 256; tile += F.G) {
        const int tok0 = tile * 128;
        f32x16 acc;
#pragma unroll
        for (int i2 = 0; i2 < 16; ++i2) acc[i2] = 0.f;
        float g4[4] = {0.f, 0.f, 0.f, 0.f}; float ss = 0.f;
        f32x4 xr[4];
        const int srow = F.tid >> 4, sc4 = (F.tid & 15) * 4;
#pragma unroll
        for (int i2 = 0; i2 < 4; ++i2) xr[i2] = *(const f32x4*)(xres + (size_t)(tok0 + srow + 32 * i2) * D + sc4);
        float wpre[5];
#pragma unroll
        for (int i2 = 0; i2 < 5; ++i2) { const int idx = F.tid + 512 * i2; wpre[i2] = 0.f; if (idx < 64 * 36) { const int k = idx / 36, o = idx % 36;
            wpre[i2] = gain[k] * (o < 4 ? wgp[k * 4 + o] : wep[k * 32 + (o - 4)]); } }
        for (int kc = 0; kc < 32; ++kc) {
            __syncthreads();
#pragma unroll
            for (int i2 = 0; i2 < 4; ++i2) { LAS float* d = xs + (srow + 32 * i2) * 65 + sc4; d[0] = xr[i2].x; d[1] = xr[i2].y; d[2] = xr[i2].z; d[3] = xr[i2].w; }
#pragma unroll
            for (int i2 = 0; i2 < 5; ++i2) { const int idx = F.tid + 512 * i2; if (idx < 64 * 36) wc[(idx / 36) * 40 + (idx % 36)] = wpre[i2]; }
            __syncthreads();
            if (kc + 1 < 32) {
#pragma unroll
                for (int i2 = 0; i2 < 4; ++i2) xr[i2] = *(const f32x4*)(xres + (size_t)(tok0 + srow + 32 * i2) * D + (kc + 1) * 64 + sc4);
#pragma unroll
                for (int i2 = 0; i2 < 5; ++i2) { const int idx = F.tid + 512 * i2; if (idx < 64 * 36) { const int k = idx / 36, o = idx % 36, kk = (kc + 1) * 64 + k;
                    wpre[i2] = gain[kk] * (o < 4 ? wgp[kk * 4 + o] : wep[kk * 32 + (o - 4)]); } } }
#pragma unroll
            for (int s2 = 0; s2 < 16; ++s2) { const int k = 32 * kh + 2 * s2 + l5;
                acc = __builtin_amdgcn_mfma_f32_32x32x2f32(xs[(32 * mt + l31) * 65 + k], wc[k * 40 + 4 + l31], acc, 0, 0, 0); }
#pragma unroll
            for (int k2 = 0; k2 < 16; ++k2) { const int k = 16 * kq + k2; const float xv = xs[tl * 65 + k]; const f32x4 wv = *(const LAS f32x4*)(wc + k * 40);
                ss = fmaf(xv, xv, ss); g4[0] = fmaf(xv, wv.x, g4[0]); g4[1] = fmaf(xv, wv.y, g4[1]); g4[2] = fmaf(xv, wv.z, g4[2]); g4[3] = fmaf(xv, wv.w, g4[3]); }
        }
#pragma unroll
        for (int rg = 0; rg < 16; ++rg) pe[(kh * 128 + 32 * mt + (rg & 3) + 8 * (rg >> 2) + 4 * l5) * 33 + l31] = acc[rg];
        { LAS float* p = pg + (kq * 128 + tl) * 5; p[0] = g4[0]; p[1] = g4[1]; p[2] = g4[2]; p[3] = g4[3]; p[4] = ss; }
        __syncthreads();
        if (F.tid < 128) { float sq = 0.f;
#pragma unroll
            for (int q = 0; q < 4; ++q) sq += pg[(q * 128 + F.tid) * 5 + 4];
            rs[F.tid] = 1.0f / sqrtf(sq * (1.0f / D) + EPS); }
        __syncthreads();
        for (int idx = F.tid; idx < 128 * 36; idx += 512) { const int t = idx / 36, o = idx % 36; float v;
            if (o < 4) v = (pg[(0 * 128 + t) * 5 + o] + pg[(1 * 128 + t) * 5 + o]) + (pg[(2 * 128 + t) * 5 + o] + pg[(3 * 128 + t) * 5 + o]);
            else v = pe[t * 33 + (o - 4)] + pe[(128 + t) * 33 + (o - 4)];
            lg[idx] = v * rs[t] + (o < 4 ? bgp[o] : bep[o - 4]); }
        __syncthreads();
        if (F.tid < 128) {
            const LAS float* q = lg + F.tid * 36;
            int gi = 0; float gm = q[0];
#pragma unroll
            for (int j2 = 1; j2 < 4; ++j2) if (q[j2] > gm) { gm = q[j2]; gi = j2; }
            float gs = 0.f;
#pragma unroll
            for (int j2 = 0; j2 < 4; ++j2) gs += __expf(q[j2] - gm);
            const float gwt = 1.0f / gs;
            const LAS float* eq = q + 4 + gi * 8;
            int j0 = 0; float m0 = eq[0];
#pragma unroll
            for (int j2 = 1; j2 < 8; ++j2) if (eq[j2] > m0) { m0 = eq[j2]; j0 = j2; }
            int j1 = -1; float m1v = -3.0e38f;
#pragma unroll
            for (int j2 = 0; j2 < 8; ++j2) if (j2 != j0 && eq[j2] > m1v) { m1v = eq[j2]; j1 = j2; }
            const float p1 = __expf(m1v - m0);
            const float w0 = gwt / (1.0f + p1), w1 = gwt * p1 / (1.0f + p1);
            const int tok = tok0 + F.tid;
            el[2 * F.tid] = gi * 8 + j0; el[2 * F.tid + 1] = gi * 8 + j1;
            ASGE[2 * tok] = gi * 8 + j0; ASGE[2 * tok + 1] = gi * 8 + j1; ASGW[2 * tok] = w0; ASGW[2 * tok + 1] = w1;
        }
        __syncthreads();
        int myrank = 0, mye = 0;
        if (F.tid < 256) { mye = el[F.tid];
            for (int e = 0; e < 32; ++e) { const unsigned long long m = __ballot(mye == e); if (mye == e) myrank = __popcll(m & ((1ull << l) - 1ull)); if (l == 0) wcnt[w * 32 + e] = __popcll(m); } }
        __syncthreads();
        if (F.tid < 256) { int off = 0; for (int w2 = 0; w2 < w; ++w2) off += wcnt[w2 * 32 + mye]; ASGR[2 * tok0 + F.tid] = off + myrank; }
        if (F.tid < 32) CNT[tile * 32 + F.tid] = wcnt[F.tid] + wcnt[32 + F.tid] + wcnt[64 + F.tid] + wcnt[96 + F.tid];
        for (int r = w; r < 128; r += 8) { const float rsd = rs[r]; const f32x4* xrp = (const f32x4*)(xres + (size_t)(tok0 + r) * D) + l; const f32x4* grp = (const f32x4*)gain + l;
            u32x2* o8 = (u32x2*)(Hb + (size_t)(tok0 + r) * D) + l;
#pragma unroll
            for (int j2 = 0; j2 < 8; ++j2) { const f32x4 v = xrp[64 * j2], g = grp[64 * j2]; u32x2 ww; ww.x = pk2(v.x * rsd * g.x, v.y * rsd * g.y); ww.y = pk2(v.z * rsd * g.z, v.w * rsd * g.w); o8[64 * j2] = ww; } }
    }
    __syncthreads();
}
__device__ __forceinline__ void ph_dispatch(ArgP ap, const Frame& F_) {
    ap = launder(ap); unsigned char* ws = ap->ws; const Frame F = relaunder(F_);
    int* CNT = (int*)(ws + SM_CNT); int* TT = (int*)(ws + SM_TT); int* ASGE = (int*)(ws + SM_ASGE); int* ASGR = (int*)(ws + SM_ASGR); int* DEST = (int*)(ws + SM_DEST); int* ROWTOK = (int*)(ws + SM_ROWTOK);
    LAS int* cl = (LAS int*)F.lds;
    LAS int* tot = cl + 256 * 32;
    LAS int* tstart = tot + 32;
    LAS int* base = tstart + 32;
    __syncthreads();
    for (int idx = F.tid; idx < 256 * 32; idx += 512) cl[idx] = CNT[idx];
    __syncthreads();
    if (F.tid < 32) { int s = 0; for (int w2 = 0; w2 < 256; ++w2) s += cl[w2 * 32 + F.tid]; tot[F.tid] = s; }
    __syncthreads();
    if (F.tid == 0) { int acc2 = 0; for (int e = 0; e < 32; ++e) { tstart[e] = acc2; acc2 += (tot[e] + 255) >> 8; }
        if (F.bid == 0) { TT[0] = acc2; for (int e = 0; e < 32; ++e) { const int n = (tot[e] + 255) >> 8; for (int i = 0; i < n; ++i) TT[1 + tstart[e] + i] = e; } } }
    __syncthreads();
    for (int tile = F.bid; tile < 256; tile += F.G) {
        if (F.tid < 32) { int s = 0; for (int w2 = 0; w2 < tile; ++w2) s += cl[w2 * 32 + F.tid]; base[F.tid] = s; }
        __syncthreads();
        if (F.tid < 256) { const int a = 2 * tile * 128 + F.tid; const int e = ASGE[a]; const int pos = tstart[e] * 256 + base[e] + ASGR[a]; DEST[a] = pos; ROWTOK[pos] = a >> 1; }
        __syncthreads();
    }
    for (int e = F.bid; e < 32; e += F.G) { const int n = (tot[e] + 255) >> 8; for (int p = tot[e] + F.tid; p < n * 256; p += 512) ROWTOK[tstart[e] * 256 + p] = 0; }
    __syncthreads();
}
__device__ __forceinline__ void ph_moe1(ArgP ap, const Frame& F_) {
    ap = launder(ap); unsigned char* ws = ap->ws; const Frame F = relaunder(F_);
    const int* TT = (const int*)(ws + SM_TT);
    LAS int* tt = (LAS int*)(F.lds + LDS_TT);
    __syncthreads();
    for (int idx = F.tid; idx < 1 + NRT_MAX; idx += 512) tt[idx] = TT[idx];
    __syncthreads();
    Moe1Sched S{(const char*)(ws + WS_H), (const char*)(ws + WS_WGU), (const int*)(ws + SM_ROWTOK), tt, F.G, F.bid};
    EpiSwiGLU E{(bf16_t*)(ws + WS_HID)};
    pg8::gemm_phase(F.lds, S, E);
}
__device__ __forceinline__ void ph_moe2(ArgP ap, const Frame& F_) {
    ap = launder(ap); unsigned char* ws = ap->ws; const Frame F = relaunder(F_);
    const int* TT = (const int*)(ws + SM_TT);
    LAS int* tt = (LAS int*)(F.lds + LDS_TT);
    __syncthreads();
    for (int idx = F.tid; idx < 1 + NRT_MAX; idx += 512) tt[idx] = TT[idx];
    __syncthreads();
    Moe2Sched S{(const char*)(ws + WS_HID), (const char*)(ws + WS_WD), tt, F.G, F.bid};
    EpiPlain E{(bf16_t*)(ws + WS_YBUF), 2048, (size_t)256 * 2048, 256};
    pg8::gemm_phase(F.lds, S, E);
}
__device__ __forceinline__ void ph_combine(ArgP ap, const Frame& F_, const int layer) {
    ap = launder(ap); unsigned char* ws = ap->ws; const Frame F = relaunder(F_);
    const bf16_t* yb = (const bf16_t*)(ws + WS_YBUF); float* xres = ap->out; bf16_t* Hb = (bf16_t*)(ws + WS_H);
    const int* DEST = (const int*)(ws + SM_DEST); const float* ASGW = (const float*)(ws + SM_ASGW);
    const float* gain = layer == 0 ? INP(float, 12) : INP(float, 24);
    for (int m = F.bid * 8 + F.wave; m < T; m += F.G * 8) {
        const int d0 = DEST[2 * m], d1 = DEST[2 * m + 1]; const float w0 = ASGW[2 * m], w1 = ASGW[2 * m + 1];
        f32x4* xr = (f32x4*)(xres + (size_t)m * D) + F.lane; const f32x4* gr = (const f32x4*)gain + F.lane;
        const u32x2* y0p = (const u32x2*)(yb + (size_t)d0 * D) + F.lane; const u32x2* y1p = (const u32x2*)(yb + (size_t)d1 * D) + F.lane;
        f32x4 v[8]; float s = 0.f;
#pragma unroll
        for (int j = 0; j < 8; ++j) { const f32x4 xv = xr[64 * j]; const u32x2 a = y0p[64 * j], c = y1p[64 * j];
            v[j].x = xv.x + w0 * bf_lo(a.x) + w1 * bf_lo(c.x); v[j].y = xv.y + w0 * bf_hi(a.x) + w1 * bf_hi(c.x);
            v[j].z = xv.z + w0 * bf_lo(a.y) + w1 * bf_lo(c.y); v[j].w = xv.w + w0 * bf_hi(a.y) + w1 * bf_hi(c.y);
            s += (v[j].x * v[j].x + v[j].y * v[j].y) + (v[j].z * v[j].z + v[j].w * v[j].w); }
        const float rstd = 1.0f / sqrtf(wave_sum(s) * (1.0f / D) + EPS);
        if (layer == 0) {
            u32x2* o8 = (u32x2*)(Hb + (size_t)m * D) + F.lane;
#pragma unroll
            for (int j = 0; j < 8; ++j) { xr[64 * j] = v[j]; const f32x4 g = gr[64 * j]; u32x2 w; w.x = pk2(v[j].x * rstd * g.x, v[j].y * rstd * g.y); w.y = pk2(v[j].z * rstd * g.z, v[j].w * rstd * g.w); o8[64 * j] = w; }
        } else {
#pragma unroll
            for (int j = 0; j < 8; ++j) { const f32x4 g = gr[64 * j]; f32x4 o; o.x = v[j].x * rstd * g.x; o.y = v[j].y * rstd * g.y; o.z = v[j].z * rstd * g.z; o.w = v[j].w * rstd * g.w; xr[64 * j] = o; }
        }
    }
}

#ifndef PH_MASK
#define PH_MASK 0xffffffffull
#endif
#define SITE(s) ((PH_MASK >> (s)) & 1ull)
__global__ void __launch_bounds__(512, 2) mk_fwd(Args args) {
    extern __shared__ __attribute__((aligned(16))) unsigned char lds_raw[];
    ArgP ap = (ArgP)__builtin_amdgcn_kernarg_segment_ptr();
    Frame F;
    F.lds = (LAS unsigned char*)lds_raw;
    F.tid = threadIdx.x; F.lane = F.tid & 63; F.wave = __builtin_amdgcn_readfirstlane(F.tid >> 6); F.G = gridDim.x; F.bid = blockIdx.x;
    volatile LAS unsigned* MISC = (volatile LAS unsigned*)(F.lds + LDS_MISC);
    if (F.tid < 64) MISC[F.tid] = 0u;
    __syncthreads();
    const int lo = ap->ph_lo, hi = ap->ph_hi;
    XcdBarrier bar = xcd_barrier_post((unsigned*)(ap->ws + WS_CTL) + CW_BAR + ap->li * XCD_BAR_WORDS, MISC + 8);
#define IN(k) (SITE(k) && lo <= (k) && (k) < hi)
#define SEAM(k) do { if ((k) + 1 < hi) xcd_barrier(bar); } while (0)
#ifndef REP_MASK
#define REP_MASK 0ull
#endif
#define RUN(k, call) if (IN(k)) { call; if constexpr (((REP_MASK >> (k)) & 1ull) != 0ull) { xcd_barrier(bar); call; } SEAM(k); }
    RUN(0, ph_prologue(ap, F))
    RUN(1, ph_inproj0(ap, F))
    RUN(2, ph_conv_attn(ap, F))
    RUN(3, ph_gates(ap, F))
    RUN(4, ph_scan(ap, F, 0))
    RUN(5, ph_scan(ap, F, 1))
    RUN(6, ph_outproj0(ap, F))
#define MOE_HALF(layer, p0) \
    RUN((p0) + 0, ph_router(ap, F, layer)) \
    RUN((p0) + 1, ph_dispatch(ap, F)) \
    RUN((p0) + 2, ph_moe1(ap, F)) \
    RUN((p0) + 3, ph_moe2(ap, F)) \
    RUN((p0) + 4, ph_combine(ap, F, layer))
#define L1_MIXER(b, p0) \
    RUN((p0) + 0, ph_l1_inproj(ap, F, b)) \
    RUN((p0) + 1, ph_l1_kv(ap, F)) \
    RUN((p0) + 2, ph_l1_rscan(ap, F)) \
    RUN((p0) + 3, ph_l1_y(ap, F)) \
    RUN((p0) + 4, ph_l1_gnorm(ap, F, b)) \
    RUN((p0) + 5, ph_l1_out(ap, F, b))
    MOE_HALF(0, 7)
    L1_MIXER(0, 12)
    L1_MIXER(1, 18)
    MOE_HALF(1, 24)
#ifdef XBAR_PROBE
    for (int i = 0; i < XBAR_PROBE; ++i) xcd_barrier(bar);
#endif
#undef MOE_HALF
#undef L1_MIXER
#undef IN
#undef SEAM
}

constexpr int N_PHASES = 29;
#ifndef MK_PER_PHASE
#define MK_PER_PHASE 0
#endif
extern "C" void kernel_launch(void* const* d_in, const int* in_sizes, int n_in, void* d_out, int out_size, void* d_ws, size_t ws_size, hipStream_t stream) {
    static int grid = 0;
    if (grid == 0) {
        if (n_in != 25 || out_size != T * D || ws_size < WS_END) { fprintf(stderr, "kernel_launch: unexpected shapes (n_in %d out %d ws %zu)\n", n_in, out_size, ws_size); grid = -1; return; }
        int dev = 0, cus = 0, per_cu = 0;
        if (hipGetDevice(&dev) != hipSuccess || hipDeviceGetAttribute(&cus, hipDeviceAttributeMultiprocessorCount, dev) != hipSuccess) { grid = -1; return; }
        if (hipFuncSetAttribute((const void*)mk_fwd, hipFuncAttributeMaxDynamicSharedMemorySize, LDS_BYTES) != hipSuccess) { fprintf(stderr, "kernel_launch: hipFuncSetAttribute failed\n"); grid = -1; return; }
        if (hipOccupancyMaxActiveBlocksPerMultiprocessor(&per_cu, (const void*)mk_fwd, 512, LDS_BYTES) != hipSuccess || per_cu < 1) fprintf(stderr, "kernel_launch: occupancy query reports %d\n", per_cu);
        (void)hipGetLastError();
        grid = cus;
    }
    if (grid < 0) return;
    (void)hipMemsetAsync((char*)d_ws + WS_CTL, 0, CTL_ZERO_BYTES, stream);
    Args a; memset(&a, 0, sizeof(a));
    for (int i = 0; i < 25; ++i) a.in[i] = d_in[i];
    a.out = (float*)d_out; a.ws = (unsigned char*)d_ws;
#if MK_PER_PHASE
    for (int p = 0; p < N_PHASES; ++p) { a.ph_lo = p; a.ph_hi = p + 1; a.li = 0; hipLaunchKernelGGL(mk_fwd, dim3(grid), dim3(512), LDS_BYTES, stream, a); }
#else
    a.ph_lo = 0; a.ph_hi = N_PHASES; a.li = 0;
    hipLaunchKernelGGL(mk_fwd, dim3(grid), dim3(512), LDS_BYTES, stream, a);
#endif
}
```

```cpp
#include <hip/hip_runtime.h>
#include <cstdio>
#include <cstdint>
#include <cstring>

#define LAS __attribute__((address_space(3)))
#define GAS __attribute__((address_space(1)))
typedef unsigned short bf16_t;
typedef short bf16x8 __attribute__((ext_vector_type(8)));
typedef float f32x4 __attribute__((ext_vector_type(4)));
typedef float f32x2 __attribute__((ext_vector_type(2)));
typedef unsigned u32x4 __attribute__((ext_vector_type(4)));
typedef unsigned u32x2 __attribute__((ext_vector_type(2)));

constexpr int T = 32768, D = 2048, SEQ = 16384;
constexpr int EV_IN = 5120, OD_IN = 12288;
constexpr int PMAX = 65536 + 32 * 256, NRT_MAX = PMAX / 256;
constexpr float EPS = 1e-6f;

constexpr size_t MiB = 1u << 20;
constexpr size_t WS_CTL = 0, CTL_ZERO_BYTES = 1 * MiB;
constexpr size_t WS_SMALL = 1 * MiB;
constexpr size_t SM_CNT = WS_SMALL + 0;
constexpr size_t SM_TT = WS_SMALL + 32 * 1024;
constexpr size_t SM_ASGE = WS_SMALL + 64 * 1024;
constexpr size_t SM_ASGR = WS_SMALL + 320 * 1024;
constexpr size_t SM_ASGW = WS_SMALL + 576 * 1024;
constexpr size_t SM_DEST = WS_SMALL + 832 * 1024;
constexpr size_t SM_ROWTOK = WS_SMALL + 1088 * 1024;
constexpr size_t WS_ROT = 4 * MiB;
constexpr size_t WS_WOD = 36 * MiB;
constexpr size_t WS_WODO = 84 * MiB;
constexpr size_t WS_WGU = 100 * MiB;
constexpr size_t WS_WD = 228 * MiB;
constexpr size_t WS_WEVI = 292 * MiB;
constexpr size_t WS_WEVO = 312 * MiB;
constexpr size_t WS_WGATE = 320 * MiB;
constexpr size_t WS_SUB = 321 * MiB;
constexpr size_t WS_CH = 329 * MiB;
constexpr size_t WS_H = 332 * MiB;
constexpr size_t ARENA = 460 * MiB;
constexpr size_t WS_PROJ0 = ARENA;
constexpr size_t WS_XC = 780 * MiB;
constexpr size_t WS_GPRE = 844 * MiB;
constexpr size_t WS_Y0 = 972 * MiB;
constexpr size_t WS_HID = ARENA;
constexpr size_t WS_YBUF = 532 * MiB;
constexpr size_t WS_QCAT = ARENA;
constexpr size_t WS_VRCAT = 588 * MiB;
constexpr size_t WS_KB = 844 * MiB;
constexpr size_t WS_KDT = 908 * MiB;
constexpr size_t WS_YB = 844 * MiB;
constexpr size_t WS_GB = 972 * MiB;
constexpr size_t WS_ROWSS = 321 * MiB;
constexpr size_t WS_STATS = 292 * MiB;
constexpr size_t WS_END = 1100 * MiB;

constexpr int CW_BAR = 4096;

constexpr int LDS_MAIN = 131072;
constexpr int LDS_MISC = LDS_MAIN;
constexpr int LDS_TT = LDS_MAIN + 256;
constexpr int LDS_BYTES = 147456;

__device__ __forceinline__ unsigned f2bf(float f) { unsigned u = __builtin_bit_cast(unsigned, f); return (u + 0x7fffu + ((u >> 16) & 1u)) >> 16; }
__device__ __forceinline__ unsigned pk2(float lo, float hi) { unsigned r; asm volatile("v_cvt_pk_bf16_f32 %0, %1, %2" : "=v"(r) : "v"(lo), "v"(hi)); return r; }
__device__ __forceinline__ float bf_lo(unsigned w) { return __builtin_bit_cast(float, w << 16); }
__device__ __forceinline__ float bf_hi(unsigned w) { return __builtin_bit_cast(float, w & 0xffff0000u); }
__device__ __forceinline__ float bf2f(bf16_t h) { return __builtin_bit_cast(float, ((unsigned)h) << 16); }
__device__ __forceinline__ float wave_sum(float v) {
#pragma unroll
    for (int o = 1; o < 64; o <<= 1) v += __shfl_xor(v, o);
    return v;
}
__device__ __forceinline__ float sigmoidf_(float x) { return __builtin_amdgcn_rcpf(1.0f + __expf(-x)); }
__device__ __forceinline__ float gelu_tanh(float x) { const float u = 0.7978845608028654f * (x + 0.044715f * x * x * x); const float e = __expf(2.0f * u); const float th = 1.0f - 2.0f * __builtin_amdgcn_rcpf(e + 1.0f); return 0.5f * x * (1.0f + th); }
__device__ __forceinline__ void unpack8(const u32x4 w, float (&f)[8]) { f[0] = bf_lo(w.x); f[1] = bf_hi(w.x); f[2] = bf_lo(w.y); f[3] = bf_hi(w.y); f[4] = bf_lo(w.z); f[5] = bf_hi(w.z); f[6] = bf_lo(w.w); f[7] = bf_hi(w.w); }
__device__ __forceinline__ u32x4 pack8(const float (&f)[8]) { u32x4 w; w.x = pk2(f[0], f[1]); w.y = pk2(f[2], f[3]); w.z = pk2(f[4], f[5]); w.w = pk2(f[6], f[7]); return w; }
#define LDS_WAIT() asm volatile("s_waitcnt lgkmcnt(0)" ::: "memory")

#define XB_TMO      128
#define XB_XCNT(j)  (256  + 64 * (j))
#define XB_XSUB(j)  (1280 + 64 * (j))
#define XB_XGEN(j)  (2304 + 64 * (j))
#define XB_TOP      3328
#define XB_TOPGEN   3392
#define XCD_BAR_WORDS 3456
#define XB_SPIN_CAP (1u << 18)
__device__ __forceinline__ unsigned xb_ld(unsigned* p)              { return __hip_atomic_load(p, __ATOMIC_RELAXED, __HIP_MEMORY_SCOPE_AGENT); }
__device__ __forceinline__ unsigned xb_add(unsigned* p, unsigned v) { return __hip_atomic_fetch_add(p, v, __ATOMIC_RELAXED, __HIP_MEMORY_SCOPE_AGENT); }
__device__ __forceinline__ unsigned xb_xcc_id() { return (unsigned)__builtin_amdgcn_s_getreg((3 << 11) | 20) & 0xFu; }
#define XB_SPIN(cond, bar) do { unsigned _sp = 0; while (cond) { __builtin_amdgcn_s_sleep(1); \
    if ((++_sp & 255u) == 0u) { if (xb_ld(&(bar)[XB_TMO])) break; if (_sp > XB_SPIN_CAP) { atomicAdd(&(bar)[XB_TMO], 1u); break; } } } } while (0)
struct XcdBarrier { unsigned* bar; unsigned x; volatile LAS unsigned* st; };
__device__ __forceinline__ XcdBarrier xcd_barrier_post(unsigned* bar, volatile LAS unsigned* st) {
    XcdBarrier b; b.bar = bar; b.x = xb_xcc_id(); b.st = st;
    if (threadIdx.x == 0) (void)xb_add(&bar[XB_XCNT(b.x)], 1u);
    return b;
}
__device__ __forceinline__ void xcd_barrier_complete(unsigned* bar, unsigned x, unsigned& nloc, unsigned& nx) {
    const unsigned G = gridDim.x * gridDim.y * gridDim.z;
    unsigned sum, cnt, mine, sp = 0u;
    for (;;) {
        sum = 0u; cnt = 0u; mine = 0u;
#pragma unroll
        for (unsigned j = 0; j < 16; ++j) { const unsigned c = xb_ld(&bar[XB_XCNT(j)]); sum += c; cnt += (c > 0u) ? 1u : 0u; mine = (j == x) ? c : mine; }
        if (sum == G) break;
        __builtin_amdgcn_s_sleep(1);
        if ((++sp & 255u) == 0u) { if (xb_ld(&bar[XB_TMO])) break; if (sp > XB_SPIN_CAP) { atomicAdd(&bar[XB_TMO], 1u); break; } }
    }
    nloc = mine > 0u ? mine : 1u; nx = cnt > 0u ? cnt : 1u;
}
__device__ __forceinline__ void xcd_barrier(const XcdBarrier& b) {
    asm volatile("s_waitcnt vmcnt(0)" ::: "memory");
    __syncthreads();
    if (threadIdx.x == 0) {
        unsigned* bar = b.bar;
        __builtin_amdgcn_s_waitcnt(0);
        unsigned nloc = b.st[0], nx = b.st[1];
        if (nloc == 0u) { xcd_barrier_complete(bar, b.x, nloc, nx); b.st[0] = nloc; b.st[1] = nx; }
        const unsigned old = xb_add(&bar[XB_XSUB(b.x)], 1u);
        const unsigned gen = old / nloc;
        if (old + 1u == (gen + 1u) * nloc) {
            __builtin_amdgcn_fence(__ATOMIC_RELEASE, "agent");
            asm volatile("s_waitcnt vmcnt(0)" ::: "memory");
            const unsigned og = xb_add(&bar[XB_TOP], 1u);
            const unsigned tg = og / nx;
            if (og + 1u == (tg + 1u) * nx) xb_add(&bar[XB_TOPGEN], 1u);
            else XB_SPIN(xb_ld(&bar[XB_TOPGEN]) == tg, bar);
            __builtin_amdgcn_fence(__ATOMIC_ACQUIRE, "agent");
            xb_add(&bar[XB_XGEN(b.x)], 1u);
            asm volatile("s_waitcnt vmcnt(0)" ::: "memory");
        } else {
            XB_SPIN(xb_ld(&bar[XB_XGEN(b.x)]) == gen, bar);
            __builtin_amdgcn_fence(__ATOMIC_ACQUIRE, "agent");
            asm volatile("s_waitcnt vmcnt(0)" ::: "memory");
        }
    }
    __syncthreads();
}

#ifndef PG8_ALIGN_EPI
#define PG8_ALIGN_EPI 1
#endif
namespace pg8 {
constexpr int BM = 256, BK = 64, HALF = 128, HTB = HALF * BK * 2, STAGE_BYTES = 8 * HTB, NXCD = 8, WGM = 8;
__device__ __forceinline__ int lds_byte(int r, int c) { const int st = (r >> 4) * 2 + (c >> 5), rr = r & 15, cc = c & 31, ob = rr * 64 + cc * 2; return st * 1024 + (ob ^ (((ob >> 9) & 1) << 5)); }
__device__ __forceinline__ void stage_rc(int b, int& R, int& C) { const int st = b / 1024, sb = b % 1024, swz = sb ^ (((sb >> 9) & 1) << 5); R = (st >> 1) * 16 + swz / 64; C = (st & 1) * 32 + (swz % 64) / 2; }
__device__ __forceinline__ int perm32(int rho) { const int n = rho >> 4, i = rho & 15; return 8 * (i >> 2) + 4 * n + (i & 3); }

struct Unit { const char* a; const char* b; int pm, pn, x0, x1; };

__device__ __forceinline__ void tile_order(int L, int nM, int nN, int& pm, int& pn) {
    const int nwg = nM * nN; int wgid = L;
    { const int q = nwg / NXCD, r = nwg % NXCD, xcd = wgid % NXCD, off = wgid / NXCD; wgid = (xcd < r ? xcd * (q + 1) : r * (q + 1) + (xcd - r) * q) + off; }
    const int nig = WGM * nN, gid = wgid / nig, fm = gid * WGM, gsz = (nM - fm) < WGM ? (nM - fm) : WGM;
    pm = fm + ((wgid % nig) % gsz); pn = (wgid % nig) / gsz;
}

template <class Epi, class Sched>
__device__ __forceinline__ void gemm_phase(LAS unsigned char* lds, const Sched& S, const Epi& E) {
    int tid_ = threadIdx.x; asm volatile("" : "+v"(tid_));
    const int tid = tid_, wid = __builtin_amdgcn_readfirstlane(tid >> 6), lane = tid & 63, wr = wid >> 2, wc = wid & 3, fr = lane & 15, fq = lane >> 4;
    const int nt = S.K / BK;
    int sR[2], sC[2];
    unsigned voffB[2];
#pragma unroll
    for (int i = 0; i < 2; ++i) { stage_rc(tid * 16 + i * 8192, sR[i], sC[i]); const int Rb = Epi::PERM ? ((sR[i] & ~31) + perm32(sR[i] & 31)) : sR[i];
        voffB[i] = (unsigned)(Rb * S.ldb + sC[i]) * 2u; }
    const size_t kstep = (size_t)(BK * 2);
    const size_t hstepB = (size_t)HALF * S.ldb * 2, hstepA = (size_t)HALF * S.lda * 2;
    const unsigned ldsw = (unsigned)wid * 1024u;
    const int aoff = lds_byte(wr * 64 + fr, fq * 8), boff = lds_byte(wc * 32 + fr, fq * 8);
#define PG8_SA(b, h) (((b) * 2 + (h)) * HTB)
#define PG8_SB(b, h) ((4 + (b) * 2 + (h)) * HTB)
#define PG8_STAGE2(bufoff, gbase, v0, v1) do { \
        __builtin_amdgcn_global_load_lds((const unsigned*)((const char*)(gbase) + (v0)), (LAS unsigned*)(lds + (bufoff) + ldsw), 16, 0, 0); \
        __builtin_amdgcn_global_load_lds((const unsigned*)((const char*)(gbase) + (v1)), (LAS unsigned*)(lds + (bufoff) + ldsw + 8192), 16, 0, 0); } while (0)
#define PG8_STAGEB(b, h, gbase) PG8_STAGE2(PG8_SB(b, h), (gbase) + (h) * hstepB, voffB[0], voffB[1])
#define PG8_STAGEA(b, h, gbase, V) do { if constexpr (Sched::GATHER) { PG8_STAGE2(PG8_SA(b, h), gbase, V[h][0], V[h][1]); } else { PG8_STAGE2(PG8_SA(b, h), (gbase) + (h) * hstepA, V[0][0], V[0][1]); } } while (0)
#define PG8_LDA(dst, b, h) do { _Pragma("unroll") for (int m = 0; m < 4; ++m) _Pragma("unroll") for (int k = 0; k < 2; ++k) dst[m][k] = *(const LAS bf16x8*)(lds + PG8_SA(b, h) + aoff + m * 2048 + k * 1024); } while (0)
#define PG8_LDB(dst, b, h) do { _Pragma("unroll") for (int n = 0; n < 2; ++n) _Pragma("unroll") for (int k = 0; k < 2; ++k) dst[n][k] = *(const LAS bf16x8*)(lds + PG8_SB(b, h) + boff + n * 2048 + k * 1024); } while (0)
#define PG8_MMA(ai, bj, At, Bt) do { __builtin_amdgcn_s_setprio(1); _Pragma("unroll") for (int m = 0; m < 4; ++m) _Pragma("unroll") for (int n = 0; n < 2; ++n) _Pragma("unroll") for (int k = 0; k < 2; ++k) \
        acc[ai][bj][m][n] = __builtin_amdgcn_mfma_f32_16x16x32_bf16(Bt[n][k], At[m][k], acc[ai][bj][m][n], 0, 0, 0); __builtin_amdgcn_s_setprio(0); } while (0)
#define PG8_WAIT_V(n) asm volatile("s_waitcnt vmcnt(" #n ")" ::: "memory")
#define PG8_WAIT_L(n) asm volatile("s_waitcnt lgkmcnt(" #n ")" ::: "memory")
#define PG8_BAR __builtin_amdgcn_s_barrier()
#define PG8_SCHED __builtin_amdgcn_sched_barrier(0)
#define PG8_CALC_VA(u, V) do { _Pragma("unroll") for (int _h = 0; _h < 2; ++_h) _Pragma("unroll") for (int _i = 0; _i < 2; ++_i) { \
        if constexpr (Sched::GATHER) V[_h][_i] = S.row_off(u, sR[_i] + HALF * _h) + (unsigned)sC[_i] * 2u; \
        else V[_h][_i] = (unsigned)((sR[_i] + HALF * _h) * S.lda + sC[_i]) * 2u; } } while (0)
    Unit cur, nxt; int ui = 0;
    if (!S.next(0, cur)) return;
    f32x4 acc[2][2][4][2];
#pragma unroll
    for (int a = 0; a < 2; ++a)
#pragma unroll
        for (int b = 0; b < 2; ++b)
#pragma unroll
            for (int m = 0; m < 4; ++m)
#pragma unroll
                for (int n = 0; n < 2; ++n) acc[a][b][m][n] = (f32x4){0.f, 0.f, 0.f, 0.f};
    bf16x8 At[4][2], B0[2][2], B1[2][2];
    unsigned vA[2][2], vN[2][2];
    PG8_CALC_VA(cur, vA);
    const char* cA = cur.a; const char* cB = cur.b;
    PG8_STAGEB(0, 0, cB); PG8_STAGEB(0, 1, cB); PG8_STAGEA(0, 0, cA, vA); PG8_STAGEA(0, 1, cA, vA);
    if (wr == 1) PG8_BAR;
    PG8_WAIT_V(2); PG8_BAR;
    PG8_STAGEB(1, 0, cB + kstep); PG8_STAGEA(1, 0, cA + kstep, vA); PG8_STAGEB(1, 1, cB + kstep);
    PG8_WAIT_V(6); PG8_BAR;
    for (;;) {
        const bool has_next = S.next(ui + 1, nxt);
        const char* nA = has_next ? nxt.a : cA; const char* nB = has_next ? nxt.b : cB;
        if constexpr (Sched::GATHER) { if (has_next) { PG8_CALC_VA(nxt, vN); } else {
#pragma unroll
            for (int _h = 0; _h < 2; ++_h)
#pragma unroll
                for (int _i = 0; _i < 2; ++_i) vN[_h][_i] = vA[_h][_i]; } }
#pragma unroll 1
        for (int t = 0; t < nt; t += 2) {
            const bool last = (t == nt - 2);
            const char* a1 = cA + (size_t)(t + 1) * kstep;
            const char* a2 = last ? nA : cA + (size_t)(t + 2) * kstep; const char* b2 = last ? nB : cB + (size_t)(t + 2) * kstep;
            const char* a3 = a2 + kstep; const char* b3 = b2 + kstep;
            unsigned vS[2][2];
#pragma unroll
            for (int _h = 0; _h < 2; ++_h)
#pragma unroll
                for (int _i = 0; _i < 2; ++_i) { if constexpr (Sched::GATHER) vS[_h][_i] = last ? vN[_h][_i] : vA[_h][_i]; else vS[_h][_i] = vA[_h][_i]; }
            PG8_LDB(B0, 0, 0); PG8_LDB(B1, 0, 1); PG8_SCHED; PG8_LDA(At, 0, 0); PG8_STAGEA(1, 1, a1, vA);
            PG8_WAIT_V(8); PG8_WAIT_L(0); PG8_BAR; PG8_MMA(0, 0, At, B0); PG8_MMA(0, 1, At, B1); PG8_BAR; PG8_SCHED;
            PG8_LDA(At, 0, 1); PG8_STAGEB(0, 0, b2); PG8_STAGEB(0, 1, b2); PG8_STAGEA(0, 0, a2, vS);
            PG8_WAIT_V(8); PG8_WAIT_L(0); PG8_BAR; PG8_MMA(1, 0, At, B0); PG8_MMA(1, 1, At, B1); PG8_BAR; PG8_SCHED;
            PG8_LDB(B0, 1, 0); PG8_LDB(B1, 1, 1); PG8_SCHED; PG8_LDA(At, 1, 0); PG8_STAGEA(0, 1, a2, vS);
            PG8_WAIT_V(8); PG8_WAIT_L(0); PG8_BAR; PG8_MMA(0, 0, At, B0); PG8_MMA(0, 1, At, B1); PG8_BAR; PG8_SCHED;
            PG8_LDA(At, 1, 1); PG8_STAGEB(1, 0, b3); PG8_STAGEB(1, 1, b3); PG8_STAGEA(1, 0, a3, vS);
            PG8_WAIT_V(8); PG8_WAIT_L(0); PG8_BAR; PG8_MMA(1, 0, At, B0); PG8_MMA(1, 1, At, B1); PG8_BAR; PG8_SCHED;
        }
#if PG8_ALIGN_EPI
        if (wr == 0) PG8_BAR;
#endif
        E(acc, cur, wr, wc, fr, fq);
        if (!has_next) break;
#pragma unroll
        for (int a = 0; a < 2; ++a)
#pragma unroll
            for (int b = 0; b < 2; ++b)
#pragma unroll
                for (int m = 0; m < 4; ++m)
#pragma unroll
                    for (int n = 0; n < 2; ++n) acc[a][b][m][n] = (f32x4){0.f, 0.f, 0.f, 0.f};
        cur = nxt; cA = nA; cB = nB; ++ui;
        if constexpr (Sched::GATHER) {
#pragma unroll
            for (int _h = 0; _h < 2; ++_h)
#pragma unroll
                for (int _i = 0; _i < 2; ++_i) vA[_h][_i] = vN[_h][_i]; }
#if PG8_ALIGN_EPI
        if (wr == 1) PG8_BAR;
#endif
    }
    PG8_WAIT_V(0);
#if !PG8_ALIGN_EPI
    if (wr == 0) PG8_BAR;
#endif
    PG8_BAR;
#undef PG8_SA
#undef PG8_SB
#undef PG8_STAGE2
#undef PG8_STAGEA
#undef PG8_STAGEB
#undef PG8_LDA
#undef PG8_LDB
#undef PG8_MMA
#undef PG8_WAIT_V
#undef PG8_WAIT_L
#undef PG8_BAR
#undef PG8_SCHED
#undef PG8_CALC_VA
}

template <int nM, int nN, int LDA, int LDB, int KK>
struct DenseSched {
    static constexpr bool GATHER = false;
    static constexpr int K = KK, lda = LDA, ldb = LDB;
    const char* A; const char* B; int G, c;
    __device__ __forceinline__ bool next(int i, Unit& u) const {
        const int L = i * G + c; if (L >= nM * nN) return false;
        int pm, pn; tile_order(L, nM, nN, pm, pn);
        u.pm = pm; u.pn = pn; u.x0 = 0; u.x1 = 0; u.a = A + (size_t)pm * BM * lda * 2; u.b = B + (size_t)pn * BM * ldb * 2; return true;
    }
    __device__ __forceinline__ unsigned row_off(const Unit&, int) const { return 0u; }
};
}

typedef const f32x4 (&AccRef)[2][2][4][2];

struct EpiPlain {
    static constexpr bool PERM = true;
    bf16_t* out; int ldc; size_t pm_stride, pn_stride;
    __device__ __forceinline__ void operator()(AccRef acc, const pg8::Unit& u, int wr, int wc, int fr, int fq) const {
        bf16_t* tile = out + (size_t)u.pm * pm_stride + (size_t)u.pn * pn_stride;
        int r0 = wr * 64 + fr, c0 = wc * 32 + 8 * fq; asm volatile("" : "+v"(r0), "+v"(c0));
#pragma unroll
        for (int ai = 0; ai < 2; ++ai)
#pragma unroll
            for (int m = 0; m < 4; ++m) { bf16_t* rowp = tile + (size_t)(r0 + ai * 128 + m * 16) * ldc + c0;
#pragma unroll
                for (int bj = 0; bj < 2; ++bj) { const f32x4 v0 = acc[ai][bj][m][0], v1 = acc[ai][bj][m][1];
                    u32x4 w; w.x = pk2(v0[0], v0[1]); w.y = pk2(v0[2], v0[3]); w.z = pk2(v1[0], v1[1]); w.w = pk2(v1[2], v1[3]);
                    *(u32x4*)(rowp + bj * 128) = w; } }
    }
};
struct EpiUnitPtr {
    static constexpr bool PERM = true;
    bf16_t* out; int ldc;
    __device__ __forceinline__ void operator()(AccRef acc, const pg8::Unit& u, int wr, int wc, int fr, int fq) const {
        bf16_t* tile = out + (((size_t)(unsigned)u.x1 << 32) | (size_t)(unsigned)u.x0);
        int r0 = wr * 64 + fr, c0 = wc * 32 + 8 * fq; asm volatile("" : "+v"(r0), "+v"(c0));
#pragma unroll
        for (int ai = 0; ai < 2; ++ai)
#pragma unroll
            for (int m = 0; m < 4; ++m) { bf16_t* rowp = tile + (size_t)(r0 + ai * 128 + m * 16) * ldc + c0;
#pragma unroll
                for (int bj = 0; bj < 2; ++bj) { const f32x4 v0 = acc[ai][bj][m][0], v1 = acc[ai][bj][m][1];
                    u32x4 w; w.x = pk2(v0[0], v0[1]); w.y = pk2(v0[2], v0[3]); w.z = pk2(v1[0], v1[1]); w.w = pk2(v1[2], v1[3]);
                    *(u32x4*)(rowp + bj * 128) = w; } }
    }
};
struct EpiResid {
    static constexpr bool PERM = false;
    const float* base; float* out; int row0; float* rowss;
    __device__ __forceinline__ void operator()(AccRef acc, const pg8::Unit& u, int wr, int wc, int fr, int fq) const {
        int r0 = row0 + u.pm * 256 + wr * 64 + fr, c0 = u.pn * 256 + wc * 32 + 4 * fq; asm volatile("" : "+v"(r0), "+v"(c0));
#pragma unroll
        for (int ai = 0; ai < 2; ++ai)
#pragma unroll
            for (int m = 0; m < 4; ++m) { const int row = r0 + ai * 128 + m * 16; const size_t off = (size_t)row * D + c0; float sq = 0.f;
#pragma unroll
                for (int bj = 0; bj < 2; ++bj)
#pragma unroll
                    for (int n = 0; n < 2; ++n) { const f32x4 bs = *(const f32x4*)(base + off + bj * 128 + n * 16); const f32x4 o = bs + acc[ai][bj][m][n]; *(f32x4*)(out + off + bj * 128 + n * 16) = o;
                        sq += (o[0] * o[0] + o[1] * o[1]) + (o[2] * o[2] + o[3] * o[3]); }
                sq += __shfl_xor(sq, 16); sq += __shfl_xor(sq, 32);
                if (fq == 0) rowss[(size_t)row * 32 + u.pn * 4 + wc] = sq;
                asm volatile("" ::: "memory"); }
    }
};
struct EpiSwiGLU {
    static constexpr bool PERM = true;
    bf16_t* hid;
    __device__ __forceinline__ void operator()(AccRef acc, const pg8::Unit& u, int wr, int wc, int fr, int fq) const {
        bf16_t* tile = hid + (size_t)u.pm * 256 * 512 + u.pn * 128;
        int r0 = wr * 64 + fr, c0 = wc * 32 + 8 * fq; asm volatile("" : "+v"(r0), "+v"(c0));
#pragma unroll
        for (int ai = 0; ai < 2; ++ai)
#pragma unroll
            for (int m = 0; m < 4; ++m) { bf16_t* rowp = tile + (size_t)(r0 + ai * 128 + m * 16) * 512 + c0;
                float o[8];
#pragma unroll
                for (int n = 0; n < 2; ++n)
#pragma unroll
                    for (int j = 0; j < 4; ++j) { const float g = acc[ai][0][m][n][j], up = acc[ai][1][m][n][j]; o[n * 4 + j] = g * sigmoidf_(g) * up; }
                *(u32x4*)rowp = pack8(o); }
    }
};
struct EpiSilu {
    static constexpr bool PERM = true;
    bf16_t* out; int ldc;
    __device__ __forceinline__ void operator()(AccRef acc, const pg8::Unit& u, int wr, int wc, int fr, int fq) const {
        bf16_t* tile = out + (size_t)u.pm * 256 * ldc + u.pn * 256;
        int r0 = wr * 64 + fr, c0 = wc * 32 + 8 * fq; asm volatile("" : "+v"(r0), "+v"(c0));
#pragma unroll
        for (int ai = 0; ai < 2; ++ai)
#pragma unroll
            for (int m = 0; m < 4; ++m) { bf16_t* rowp = tile + (size_t)(r0 + ai * 128 + m * 16) * ldc + c0;
#pragma unroll
                for (int bj = 0; bj < 2; ++bj) { float o[8];
#pragma unroll
                    for (int n = 0; n < 2; ++n)
#pragma unroll
                        for (int j = 0; j < 4; ++j) { const float g = acc[ai][bj][m][n][j]; o[n * 4 + j] = g * sigmoidf_(g); }
                    *(u32x4*)(rowp + bj * 128) = pack8(o); } }
    }
};
struct EpiRotary {
    static constexpr bool PERM = true;
    bf16_t* out; int ldc; size_t pm_stride, pn_stride; const float* rot; int tok0; float scale;
    __device__ __forceinline__ void operator()(AccRef acc, const pg8::Unit& u, int wr, int wc, int fr, int fq) const {
        bf16_t* tile = out + (size_t)u.pm * pm_stride + (size_t)u.pn * pn_stride;
        int r0 = wr * 64 + fr, c0 = wc * 32 + 8 * fq; asm volatile("" : "+v"(r0), "+v"(c0));
#pragma unroll
        for (int ai = 0; ai < 2; ++ai)
#pragma unroll
            for (int m = 0; m < 4; ++m) { const int r = r0 + ai * 128 + m * 16; bf16_t* rowp = tile + (size_t)r * ldc + c0;
                const float* rt = rot + ((size_t)(tok0 + u.pm * 256 + r) * 128 + (c0 >> 1)) * 2;
#pragma unroll
                for (int bj = 0; bj < 2; ++bj) { const f32x4 cs0 = *(const f32x4*)(rt + bj * 128), cs1 = *(const f32x4*)(rt + bj * 128 + 4);
                    const f32x4 v0 = acc[ai][bj][m][0], v1 = acc[ai][bj][m][1]; float o[8];
                    o[0] = (v0[0] * cs0[0] - v0[1] * cs0[1]) * scale; o[1] = (v0[1] * cs0[0] + v0[0] * cs0[1]) * scale;
                    o[2] = (v0[2] * cs0[2] - v0[3] * cs0[3]) * scale; o[3] = (v0[3] * cs0[2] + v0[2] * cs0[3]) * scale;
                    o[4] = (v1[0] * cs1[0] - v1[1] * cs1[1]) * scale; o[5] = (v1[1] * cs1[0] + v1[0] * cs1[1]) * scale;
                    o[6] = (v1[2] * cs1[2] - v1[3] * cs1[3]) * scale; o[7] = (v1[3] * cs1[2] + v1[2] * cs1[3]) * scale;
                    *(u32x4*)(rowp + bj * 128) = pack8(o); } }
    }
};
struct EpiSprime {
    static constexpr bool PERM = true;
    bf16_t* qcat;
    __device__ __forceinline__ void operator()(AccRef acc, const pg8::Unit& u, int wr, int wc, int fr, int fq) const {
        bf16_t* tile = qcat + ((size_t)u.x0 * 16384 + (size_t)u.pm * 256) * 512;
        const float l2g = __log2f(1.0f - exp2f(-5.0f - (float)u.x0));
        int r0 = wr * 64 + fr, c0 = wc * 32 + 8 * fq; asm volatile("" : "+v"(r0), "+v"(c0));
#pragma unroll
        for (int bj = 0; bj < 2; ++bj) {
            float cf[8];
#pragma unroll
            for (int j = 0; j < 8; ++j) cf[j] = __builtin_amdgcn_exp2f(-(float)(c0 + bj * 128 + j + 1) * l2g);
#pragma unroll
            for (int ai = 0; ai < 2; ++ai)
#pragma unroll
                for (int m = 0; m < 4; ++m) { const int r = r0 + ai * 128 + m * 16; bf16_t* rowp = tile + (size_t)r * 512 + c0; float o[8];
#pragma unroll
                    for (int n = 0; n < 2; ++n)
#pragma unroll
                        for (int j = 0; j < 4; ++j) { const int c = c0 + bj * 128 + n * 4 + j; const unsigned keep = ~(unsigned)((r - c) >> 31);
                            o[n * 4 + j] = __builtin_bit_cast(float, __builtin_bit_cast(unsigned, acc[ai][bj][m][n][j] * cf[n * 4 + j]) & keep); }
                    *(u32x4*)(rowp + bj * 128) = pack8(o); }
        }
    }
};
struct EpiY {
    static constexpr bool PERM = true;
    bf16_t* yb; f32x2* stats;
    __device__ __forceinline__ void operator()(AccRef acc, const pg8::Unit& u, int wr, int wc, int fr, int fq) const {
        bf16_t* tile = yb + (size_t)u.pm * 256 * 4096 + u.x0 * 512 + u.pn * 256;
        const float l2g = __log2f(1.0f - exp2f(-5.0f - (float)u.x0));
        int r0 = wr * 64 + fr, c0 = wc * 32 + 8 * fq; asm volatile("" : "+v"(r0), "+v"(c0));
#pragma unroll
        for (int ai = 0; ai < 2; ++ai)
#pragma unroll
            for (int m = 0; m < 4; ++m) { const int r = r0 + ai * 128 + m * 16; bf16_t* rowp = tile + (size_t)r * 4096 + c0; const float rf = __builtin_amdgcn_exp2f((float)(r + 1) * l2g);
                float s1 = 0.f, s2 = 0.f;
#pragma unroll
                for (int bj = 0; bj < 2; ++bj) { const f32x4 v0 = acc[ai][bj][m][0] * rf, v1 = acc[ai][bj][m][1] * rf;
                    s1 += (v0[0] + v0[1]) + (v0[2] + v0[3]) + (v1[0] + v1[1]) + (v1[2] + v1[3]);
                    s2 += (v0[0] * v0[0] + v0[1] * v0[1]) + (v0[2] * v0[2] + v0[3] * v0[3]) + (v1[0] * v1[0] + v1[1] * v1[1]) + (v1[2] * v1[2] + v1[3] * v1[3]);
                    u32x4 w; w.x = pk2(v0[0], v0[1]); w.y = pk2(v0[2], v0[3]); w.z = pk2(v1[0], v1[1]); w.w = pk2(v1[2], v1[3]);
                    *(u32x4*)(rowp + bj * 128) = w; }
                s1 += __shfl_xor(s1, 16); s2 += __shfl_xor(s2, 16); s1 += __shfl_xor(s1, 32); s2 += __shfl_xor(s2, 32);
                if (fq == 0) { f32x2 st; st.x = s1; st.y = s2; stats[((size_t)(u.pm * 256 + r) * 8 + u.x0) * 8 + u.pn * 4 + wc] = st; } }
    }
};
struct EpiGnorm {
    static constexpr bool PERM = true;
    bf16_t* yb; const f32x2* stats; const float* gain;
    __device__ __forceinline__ void operator()(AccRef acc, const pg8::Unit& u, int wr, int wc, int fr, int fq) const {
        const int h = u.pn >> 1;
        bf16_t* tile = yb + (size_t)u.pm * 256 * 4096 + u.pn * 256;
        const float* gn = gain + u.pn * 256;
        int r0 = wr * 64 + fr, c0 = wc * 32 + 8 * fq; asm volatile("" : "+v"(r0), "+v"(c0));
#pragma unroll
        for (int ai = 0; ai < 2; ++ai)
#pragma unroll
            for (int m = 0; m < 4; ++m) { const int r = r0 + ai * 128 + m * 16; bf16_t* rowp = tile + (size_t)r * 4096 + c0;
                const f32x4* sp = (const f32x4*)(stats + ((size_t)(u.pm * 256 + r) * 8 + h) * 8);
                const f32x4 a0 = sp[0], a1 = sp[1], a2 = sp[2], a3 = sp[3];
                const float s1 = (a0.x + a0.z) + (a1.x + a1.z) + (a2.x + a2.z) + (a3.x + a3.z), s2 = (a0.y + a0.w) + (a1.y + a1.w) + (a2.y + a2.w) + (a3.y + a3.w);
                const float mu = s1 * (1.0f / 512.0f); const float rstd = __builtin_amdgcn_rsqf(fmaxf(s2 * (1.0f / 512.0f) - mu * mu, 0.f) + EPS);
#pragma unroll
                for (int bj = 0; bj < 2; ++bj) { float y[8]; unpack8(*(const u32x4*)(rowp + bj * 128), y);
                    const f32x4 g0 = *(const f32x4*)(gn + c0 + bj * 128), g1 = *(const f32x4*)(gn + c0 + bj * 128 + 4);
                    const float gg[8] = {g0.x, g0.y, g0.z, g0.w, g1.x, g1.y, g1.z, g1.w}; float o[8];
#pragma unroll
                    for (int n = 0; n < 2; ++n)
#pragma unroll
                        for (int j = 0; j < 4; ++j) { const float g = acc[ai][bj][m][n][j]; o[n * 4 + j] = g * sigmoidf_(g) * ((y[n * 4 + j] - mu) * rstd * gg[n * 4 + j]); }
                    *(u32x4*)(rowp + bj * 128) = pack8(o); } }
    }
};
struct EpiRotaryT {
    static constexpr bool PERM = true;
    bf16_t* out; bf16_t* kdt; const float* rot; int tok0; float scale;
    __device__ __forceinline__ void operator()(AccRef acc, const pg8::Unit& u, int wr, int wc, int fr, int fq) const {
        bf16_t* tile = out + (size_t)u.pm * 256 * 2048 + (size_t)u.pn * 256;
        bf16_t* ttile = kdt + (size_t)u.pn * 256 * 16384 + (size_t)u.pm * 256;
        const float l2g = __log2f(1.0f - exp2f(-5.0f - (float)u.pn));
        int r0 = wr * 64 + fr, c0 = wc * 32 + 8 * fq; asm volatile("" : "+v"(r0), "+v"(c0));
#pragma unroll
        for (int ai = 0; ai < 2; ++ai)
#pragma unroll
            for (int m = 0; m < 4; ++m) { const int r = r0 + ai * 128 + m * 16; bf16_t* rowp = tile + (size_t)r * 2048 + c0;
                const float* rt = rot + ((size_t)(tok0 + u.pm * 256 + r) * 128 + (c0 >> 1)) * 2;
                const float dk = __builtin_amdgcn_exp2f((float)(255 - r) * l2g);
#pragma unroll
                for (int bj = 0; bj < 2; ++bj) { const f32x4 cs0 = *(const f32x4*)(rt + bj * 128), cs1 = *(const f32x4*)(rt + bj * 128 + 4);
                    const f32x4 v0 = acc[ai][bj][m][0], v1 = acc[ai][bj][m][1]; float o[8];
                    o[0] = (v0[0] * cs0[0] - v0[1] * cs0[1]) * scale; o[1] = (v0[1] * cs0[0] + v0[0] * cs0[1]) * scale;
                    o[2] = (v0[2] * cs0[2] - v0[3] * cs0[3]) * scale; o[3] = (v0[3] * cs0[2] + v0[2] * cs0[3]) * scale;
                    o[4] = (v1[0] * cs1[0] - v1[1] * cs1[1]) * scale; o[5] = (v1[1] * cs1[0] + v1[0] * cs1[1]) * scale;
                    o[6] = (v1[2] * cs1[2] - v1[3] * cs1[3]) * scale; o[7] = (v1[3] * cs1[2] + v1[2] * cs1[3]) * scale;
                    *(u32x4*)(rowp + bj * 128) = pack8(o);
                    bf16_t* tp = ttile + (size_t)(c0 + bj * 128) * 16384 + r;
#pragma unroll
                    for (int j = 0; j < 8; ++j) tp[(size_t)j * 16384] = (bf16_t)f2bf(o[j] * dk); } }
    }
};

__device__ __forceinline__ int xcd_unit(int i, int G, int c) { return ((G & 7) == 0) ? i * G + (c & 7) * (G >> 3) + (c >> 3) : i * G + c; }
struct GateSched {
    static constexpr bool GATHER = false;
    const char* A; const char* B; int G, c; static constexpr int lda = 1024, ldb = 256, K = 256;
    __device__ __forceinline__ bool next(int i, pg8::Unit& u) const {
        const int L = xcd_unit(i, G, c); if (L >= 128 * 8) return false;
        const int pm = L >> 3, j = (L >> 1) & 3, pn = L & 1;
        u.pm = pm; u.pn = j * 2 + pn; u.x0 = 0; u.x1 = 0; u.a = A + ((size_t)pm * 256 * 1024 + j * 256) * 2; u.b = B + ((size_t)(j * 512 + pn * 256) * 256) * 2; return true;
    }
    __device__ __forceinline__ unsigned row_off(const pg8::Unit&, int) const { return 0u; }
};
struct Moe1Sched {
    static constexpr bool GATHER = true;
    const char* A; const char* B; const int* rowtok; const LAS int* tt; int G, c; static constexpr int lda = 2048, ldb = 2048, K = 2048;
    __device__ __forceinline__ bool next(int i, pg8::Unit& u) const {
        const int L = xcd_unit(i, G, c); if (L >= tt[0] * 4) return false;
        const int rt = L >> 2, pn = L & 3, e = tt[1 + rt];
        u.pm = rt; u.pn = pn; u.x0 = e; u.x1 = 0; u.a = A; u.b = B + ((size_t)(e * 1024 + pn * 256) * 2048) * 2; return true;
    }
    __device__ __forceinline__ unsigned row_off(const pg8::Unit& u, int r) const { return (unsigned)rowtok[u.pm * 256 + r] * (unsigned)(2048 * 2); }
};
struct Moe2Sched {
    static constexpr bool GATHER = false;
    const char* A; const char* B; const LAS int* tt; int G, c; static constexpr int lda = 512, ldb = 512, K = 512;
    __device__ __forceinline__ bool next(int i, pg8::Unit& u) const {
        const int L = xcd_unit(i, G, c); if (L >= tt[0] * 8) return false;
        const int rt = L >> 3, pn = L & 7, e = tt[1 + rt];
        u.pm = rt; u.pn = pn; u.x0 = e; u.x1 = 0; u.a = A + (size_t)rt * 256 * 512 * 2; u.b = B + ((size_t)(e * 2048 + pn * 256) * 512) * 2; return true;
    }
    __device__ __forceinline__ unsigned row_off(const pg8::Unit&, int) const { return 0u; }
};
struct SpSched {
    static constexpr bool GATHER = false;
    const char* qcat; const char* kb; int G, c; static constexpr int lda = 512, ldb = 2048, K = 256;
    __device__ __forceinline__ bool next(int i, pg8::Unit& u) const {
        const int L = xcd_unit(i, G, c); if (L >= 512) return false;
        const int h = L >> 6, n = L & 63;
        u.pm = n; u.pn = 0; u.x0 = h; u.x1 = 0; u.a = qcat + (((size_t)h * 16384 + (size_t)n * 256) * 512 + 256) * 2; u.b = kb + ((size_t)n * 256 * 2048 + h * 256) * 2; return true;
    }
    __device__ __forceinline__ unsigned row_off(const pg8::Unit&, int) const { return 0u; }
};
struct KvSched {
    static constexpr bool GATHER = false;
    const char* vr; const char* kdt; int G, c; static constexpr int lda = 512, ldb = 16384, K = 256;
    __device__ __forceinline__ bool next(int i, pg8::Unit& u) const {
        const int L = xcd_unit(i, G, c); if (L >= 1024) return false;
        const int hn = L >> 1, pe = L & 1, h = hn >> 6, n = hn & 63;
        const size_t o = ((size_t)hn * 512 + pe * 256) * 512;
        u.pm = 0; u.pn = 0; u.x0 = (int)(unsigned)((o + 256) & 0xffffffffu); u.x1 = (int)(unsigned)((o + 256) >> 32);
        u.a = vr + o * 2; u.b = kdt + ((size_t)h * 256 * 16384 + (size_t)n * 256) * 2; return true;
    }
    __device__ __forceinline__ unsigned row_off(const pg8::Unit&, int) const { return 0u; }
};
struct YSched {
    static constexpr bool GATHER = false;
    const char* qcat; const char* vr; int G, c; static constexpr int lda = 512, ldb = 512, K = 512;
    __device__ __forceinline__ bool next(int i, pg8::Unit& u) const {
        const int L = xcd_unit(i, G, c); if (L >= 1024) return false;
        const int hn = L >> 1, pn = L & 1, h = hn >> 6, n = hn & 63;
        u.pm = n; u.pn = pn; u.x0 = h; u.x1 = 0; u.a = qcat + (((size_t)h * 16384 + (size_t)n * 256) * 512) * 2; u.b = vr + (((size_t)hn * 512 + pn * 256) * 512) * 2; return true;
    }
    __device__ __forceinline__ unsigned row_off(const pg8::Unit&, int) const { return 0u; }
};
struct VtSched {
    static constexpr bool GATHER = false;
    const char* w; const char* hb; int G, c; static constexpr int lda = 2048, ldb = 2048, K = 2048;
    __device__ __forceinline__ bool next(int i, pg8::Unit& u) const {
        const int L = i * G + c; if (L >= 1024) return false;
        int pmE, n; pg8::tile_order(L, 16, 64, pmE, n);
        const int h = pmE >> 1;
        const size_t o = (((size_t)(h * 64 + n)) * 512 + (pmE & 1) * 256) * 512;
        u.pm = pmE; u.pn = n; u.x0 = (int)(unsigned)(o & 0xffffffffu); u.x1 = (int)(unsigned)(o >> 32);
        u.a = w + (size_t)pmE * 256 * 2048 * 2; u.b = hb + (size_t)n * 256 * 2048 * 2; return true;
    }
    __device__ __forceinline__ unsigned row_off(const pg8::Unit&, int) const { return 0u; }
};

struct Args { const void* in[25]; float* out; unsigned char* ws; int ph_lo, ph_hi; int li, pad; };

struct Frame {
    LAS unsigned char* lds; int tid, lane, wave, G, bid;
};

struct RmIdent { __device__ __forceinline__ int operator()(int n) const { return n; } };
struct RmOdIn { __device__ __forceinline__ int operator()(int n) const { if (n >= 4096) return n; const int r = n & 255; return (n & ~255) + (r < 128 ? 2 * r : 2 * (r - 128) + 1); } };
struct RmGU { int add; __device__ __forceinline__ int operator()(int n) const { return (n >> 7) * 256 + (n & 127) + add; } };
template <class RM>
__device__ __forceinline__ void transpose_item(const float* W, int K, int N, bf16_t* WT, const RM rm, LAS float* scr, int item, int lane) {
    const int nblk = N / 32, kb = item / nblk, nb = item % nblk, k0 = 64 * kb, n0 = 32 * nb;
#pragma unroll 8
    for (int i = 0; i < 32; ++i) { const int kk = 2 * i + (lane >> 5); scr[kk * 33 + (lane & 31)] = W[(size_t)(k0 + kk) * N + n0 + (lane & 31)]; }
    LDS_WAIT(); asm volatile("" ::: "memory");
    const int c = lane & 7;
#pragma unroll
    for (int j = 0; j < 4; ++j) { const int n = (lane >> 3) + 8 * j; const LAS float* s = scr + (8 * c) * 33 + n;
        u32x4 o; o.x = pk2(s[0 * 33], s[1 * 33]); o.y = pk2(s[2 * 33], s[3 * 33]); o.z = pk2(s[4 * 33], s[5 * 33]); o.w = pk2(s[6 * 33], s[7 * 33]);
        *(u32x4*)(WT + (size_t)rm(n0 + n) * K + k0 + 8 * c) = o; }
    LDS_WAIT(); asm volatile("" ::: "memory");
}
__device__ __forceinline__ void convert_experts(const Frame& F, const float* wg, const float* wu, const float* wd, unsigned char* ws) {
    LAS float* scr = (LAS float*)(F.lds + F.wave * 16384);
    const int gw = F.bid * 8 + F.wave, NGW = F.G * 8;
    bf16_t* gu = (bf16_t*)(ws + WS_WGU); bf16_t* dd = (bf16_t*)(ws + WS_WD);
    for (int it = gw; it < 3 * 16384; it += NGW) {
        const int which = it >> 14, r = it & 16383, e = r >> 9, ii = r & 511;
        if (which == 0) transpose_item(wg + (size_t)e * 2048 * 512, 2048, 512, gu + (size_t)e * 1024 * 2048, RmGU{0}, scr, ii, F.lane);
        else if (which == 1) transpose_item(wu + (size_t)e * 2048 * 512, 2048, 512, gu + (size_t)e * 1024 * 2048, RmGU{128}, scr, ii, F.lane);
        else transpose_item(wd + (size_t)e * 512 * 2048, 512, 2048, dd + (size_t)e * 2048 * 512, RmIdent{}, scr, ii, F.lane);
    }
}
__device__ __forceinline__ void rms_row_to_bf16(const float* xrow, const float* gain, bf16_t* orow, int lane) {
    const f32x4* xr = (const f32x4*)xrow + lane; const f32x4* gr = (const f32x4*)gain + lane;
    f32x4 v[8]; float s = 0.f;
#pragma unroll
    for (int j = 0; j < 8; ++j) { v[j] = xr[64 * j]; s += (v[j].x * v[j].x + v[j].y * v[j].y) + (v[j].z * v[j].z + v[j].w * v[j].w); }
    const float rstd = 1.0f / sqrtf(wave_sum(s) * (1.0f / D) + EPS);
    u32x2* o8 = (u32x2*)orow + lane;
#pragma unroll
    for (int j = 0; j < 8; ++j) { const f32x4 g = gr[64 * j]; u32x2 w; w.x = pk2(v[j].x * rstd * g.x, v[j].y * rstd * g.y); w.y = pk2(v[j].z * rstd * g.z, v[j].w * rstd * g.w); o8[64 * j] = w; }
}

typedef const __attribute__((address_space(4))) Args* ArgP;
__device__ __forceinline__ ArgP launder(ArgP p) { asm volatile("" : "+s"(p)); return p; }
#define INP(T_, k) ((const T_*)ap->in[k])
__device__ __forceinline__ Frame relaunder(const Frame& f) { Frame g = f; asm volatile("" : "+v"(g.tid)); g.lane = g.tid & 63; g.wave = __builtin_amdgcn_readfirstlane(g.tid >> 6); return g; }

__device__ __forceinline__ void ph_prologue(ArgP ap, const Frame& F_) {
    ap = launder(ap); unsigned char* ws = ap->ws; const Frame F = relaunder(F_);
    const int gw = F.bid * 8 + F.wave, NGW = F.G * 8, gt = F.bid * 512 + F.tid, NGT = F.G * 512;
    LAS float* scr = (LAS float*)(F.lds + F.wave * 16384);
    constexpr int I_A = 32 * 160, I_B = 32 * 64, I_C = 32 * 384, I_D = 64 * 64;
    for (int it = gw; it < I_A + I_B + I_C + I_D; it += NGW) {
        int r = it;
        if (r < I_A) { transpose_item(INP(float, 3), 2048, EV_IN, (bf16_t*)(ws + WS_WEVI), RmIdent{}, scr, r, F.lane); continue; } r -= I_A;
        if (r < I_B) { transpose_item(INP(float, 11), 2048, 2048, (bf16_t*)(ws + WS_WEVO), RmIdent{}, scr, r, F.lane); continue; } r -= I_B;
        if (r < I_C) { transpose_item(INP(float, 13), 2048, OD_IN, (bf16_t*)(ws + WS_WOD), RmOdIn{}, scr, r, F.lane); continue; } r -= I_C;
        transpose_item(INP(float, 15), 4096, 2048, (bf16_t*)(ws + WS_WODO), RmIdent{}, scr, r, F.lane);
    }
    convert_experts(F, INP(float, 21), INP(float, 22), INP(float, 23), ws);
    { bf16_t* wgp = (bf16_t*)(ws + WS_WGATE); const float* ga = INP(float, 6); const float* gx = INP(float, 8);
      for (int idx = gt; idx < 4 * 512 * 256; idx += NGT) { const int j = idx >> 17, o = (idx >> 8) & 511, kk = idx & 255, pn = o >> 8, bx = (o >> 7) & 1, ch = o & 127, g = 2 * j + pn, gk = 2 * j + (kk >> 7), i = kk & 127;
          const float v = (gk == g) ? (bx ? gx : ga)[(g * 128 + i) * 128 + ch] : 0.f; wgp[idx] = (bf16_t)f2bf(v); } }
    { float* rot = (float*)(ws + WS_ROT); const int* positions = INP(int, 1);
      for (int idx = gt; idx < T * 128; idx += NGT) { const int t = idx >> 7, i = idx & 127;
          const float inv = exp2f(-(float)i * (13.287712379549449f / 128.0f)); const float ang = (float)positions[t] * inv;
          const float k = rintf(ang * 0.15915494309189535f); float r = fmaf(-k, 6.28125f, ang); r = fmaf(-k, 1.9353071795864769e-3f, r);
          f32x2 cs; cs.x = __cosf(r); cs.y = __sinf(r); *(f32x2*)(rot + (size_t)idx * 2) = cs; } }
    { const float* x_in = INP(float, 0); const float* g = INP(float, 2); bf16_t* Hb = (bf16_t*)(ws + WS_H);
      for (int m = gw; m < T; m += NGW) rms_row_to_bf16(x_in + (size_t)m * D, g, Hb + (size_t)m * D, F.lane); }
}
__device__ __forceinline__ void ph_inproj0(ArgP ap, const Frame& F_) {
    ap = launder(ap); unsigned char* ws = ap->ws; const Frame F = relaunder(F_);
    pg8::DenseSched<128, 20, 2048, 2048, 2048> S{(const char*)(ws + WS_H), (const char*)(ws + WS_WEVI), F.G, F.bid};
    EpiPlain E{(bf16_t*)(ws + WS_PROJ0), EV_IN, (size_t)256 * EV_IN, 256};
    pg8::gemm_phase(F.lds, S, E);
}
__device__ __forceinline__ void ph_conv_attn(ArgP ap, const Frame& F_) {
    ap = launder(ap); unsigned char* ws = ap->ws; const Frame F = relaunder(F_);
    const int gt = F.bid * 512 + F.tid, NGT = F.G * 512;
    const bf16_t* proj = (const bf16_t*)(ws + WS_PROJ0);
    { bf16_t* xc = (bf16_t*)(ws + WS_XC); const float* cw = INP(float, 4); const float* cb = INP(float, 5);
      const int c8 = (gt & 127) * 8; float wk[4][8], bb[8];
#pragma unroll
      for (int j = 0; j < 8; ++j) { bb[j] = cb[c8 + j];
#pragma unroll
          for (int k = 0; k < 4; ++k) wk[k][j] = cw[k * 1024 + c8 + j]; }
      for (int t = gt >> 7; t < T; t += NGT >> 7) { const int s = t & (SEQ - 1);
          float a[8];
#pragma unroll
          for (int j = 0; j < 8; ++j) a[j] = bb[j];
#pragma unroll
          for (int k = 0; k < 4; ++k) { if (s - 3 + k >= 0) { const u32x4 w = *(const u32x4*)(proj + (size_t)(t - 3 + k) * EV_IN + c8); float f[8]; unpack8(w, f);
#pragma unroll
                  for (int j = 0; j < 8; ++j) a[j] = fmaf(wk[k][j], f[j], a[j]); } }
          *(u32x4*)(xc + (size_t)t * 1024 + c8) = pack8(a); } }
    LAS unsigned char* L = F.lds;
    LAS bf16_t* Qs = (LAS bf16_t*)(L);
    LAS bf16_t* Os = (LAS bf16_t*)(L);
    volatile LAS unsigned* flag = (volatile LAS unsigned*)(L + 104448);
    bf16_t* y0 = (bf16_t*)(ws + WS_Y0);
    const int w = F.wave, l = F.lane, l15 = l & 15, l4 = l >> 4;
    const float scale = 0.08838834764831845f;
    typedef short s16x4 __attribute__((ext_vector_type(4)));
#define ATT_TR4(r0, r1, r2, r3, base, o0, o1, o2, o3) asm volatile("ds_read_b64_tr_b16 %0, %4 offset:%5\n\tds_read_b64_tr_b16 %1, %4 offset:%6\n\tds_read_b64_tr_b16 %2, %4 offset:%7\n\tds_read_b64_tr_b16 %3, %4 offset:%8\n\ts_waitcnt lgkmcnt(0)" \
        : "=&v"(r0), "=&v"(r1), "=&v"(r2), "=&v"(r3) : "v"(base), "i"(o0), "i"(o1), "i"(o2), "i"(o3) : "memory")
    for (int u = F.bid; u < 2048; u += F.G) {
        const int b = u >> 10, h = (u >> 7) & 7, qt = u & 127; const int t0 = b * SEQ + qt * 128;
        u32x4 kr[2], vr[2];
#define ATT_LOADKV(kb_) do { const int k0_ = b * SEQ + (kb_) * 64; _Pragma("unroll") for (int i = 0; i < 2; ++i) { const int id = F.tid + 512 * i; \
            kr[i] = *(const u32x4*)(proj + (size_t)(k0_ + (id >> 4)) * EV_IN + 3072 + h * 128 + (id & 15) * 8); \
            vr[i] = *(const u32x4*)(proj + (size_t)(k0_ + (id >> 4)) * EV_IN + 4096 + h * 128 + (id & 15) * 8); } } while (0)
#define ATT_STOREKV(buf_) do { _Pragma("unroll") for (int i = 0; i < 2; ++i) { const int id = F.tid + 512 * i; \
            *(LAS u32x4*)(L + 34816 + (buf_) * 17408 + ((id >> 4) * 136 + (id & 15) * 8) * 2) = kr[i]; \
            *(LAS u32x4*)(L + 69632 + (buf_) * 17408 + ((id >> 4) * 136 + (id & 15) * 8) * 2) = vr[i]; } } while (0)
        __syncthreads();
        for (int i = 0; i < 4; ++i) { const int id = F.tid + 512 * i, row = id >> 4, ch = id & 15;
            *(LAS u32x4*)(Qs + row * 136 + ch * 8) = *(const u32x4*)(proj + (size_t)(t0 + row) * EV_IN + 2048 + h * 128 + ch * 8); }
        ATT_LOADKV(2 * qt + 1);
        ATT_STOREKV(0);
        if (F.tid == 0) flag[0] = 0u;
        __syncthreads();
        bf16x8 qf[4];
#pragma unroll
        for (int ks = 0; ks < 4; ++ks) qf[ks] = *(const LAS bf16x8*)(Qs + (16 * w + l15) * 136 + 32 * ks + 8 * l4);
        f32x4 o[8];
#pragma unroll
        for (int dt = 0; dt < 8; ++dt) o[dt] = (f32x4){0.f, 0.f, 0.f, 0.f};
        float carry = 0.f;
        const int qs = qt * 128 + 16 * w + l15;
        int cur = 0, it = 0;
        for (int kb = 2 * qt + 1; kb >= 0; --kb) {
            if (kb > 0) ATT_LOADKV(kb - 1);
            const LAS bf16_t* Kc = (const LAS bf16_t*)(L + 34816 + cur * 17408);
            if (kb * 64 < qt * 128 + 16 * w + 15 && __any(carry > -104.0f)) {
            f32x4 st[4];
#pragma unroll
            for (int kt = 0; kt < 4; ++kt) { st[kt] = (f32x4){0.f, 0.f, 0.f, 0.f};
#pragma unroll
                for (int ks = 0; ks < 4; ++ks) { const bf16x8 kf = *(const LAS bf16x8*)(Kc + (16 * kt + l15) * 136 + 32 * ks + 8 * l4);
                    st[kt] = __builtin_amdgcn_mfma_f32_16x16x32_bf16(kf, qf[ks], st[kt], 0, 0, 0); } }
            float m1[4][4], tot[4], suf[4];
#pragma unroll
            for (int kt = 0; kt < 4; ++kt) { float g = 0.f;
#pragma unroll
                for (int rg = 0; rg < 4; ++rg) { const float z = st[kt][rg] * scale; st[kt][rg] = z; const bool ok = (kb * 64 + 16 * kt + 4 * l4 + rg) < qs;
                    const float sp_ = fmaxf(z, 0.f) + __logf(1.0f + __expf(-fabsf(z)));
                    m1[kt][rg] = ok ? -sp_ : 0.f; g += m1[kt][rg]; }
                const float a = __shfl_xor(g, 16); const float ps = g + a; const float b2 = __shfl_xor(ps, 32);
                tot[kt] = ps + b2; suf[kt] = ((l4 & 1) == 0 ? a : 0.f) + ((l4 & 2) == 0 ? b2 : 0.f); }
            float pw[4][4]; float running = carry;
#pragma unroll
            for (int kt = 3; kt >= 0; --kt) { float base = running + suf[kt];
#pragma unroll
                for (int rg = 3; rg >= 0; --rg) { const bool ok = (kb * 64 + 16 * kt + 4 * l4 + rg) < qs;
                    pw[kt][rg] = ok ? __expf(m1[kt][rg] + st[kt][rg] + base) : 0.f; base += m1[kt][rg]; }
                running += tot[kt]; }
            carry = running;
            const unsigned vb = (unsigned)(size_t)(L + 69632 + cur * 17408) + (unsigned)(((4 * l4 + (l15 >> 2)) * 136 + 4 * (l15 & 3)) * 2);
#pragma unroll
            for (int a2 = 0; a2 < 2; ++a2) {
                bf16x8 pf; { const unsigned p0 = pk2(pw[2 * a2][0], pw[2 * a2][1]), p1 = pk2(pw[2 * a2][2], pw[2 * a2][3]), p2 = pk2(pw[2 * a2 + 1][0], pw[2 * a2 + 1][1]), p3 = pk2(pw[2 * a2 + 1][2], pw[2 * a2 + 1][3]);
                    const u32x4 pp = {p0, p1, p2, p3}; pf = __builtin_bit_cast(bf16x8, pp); }
#pragma unroll
                for (int dp = 0; dp < 4; ++dp) { s16x4 v0, v1, v2, v3;
                    if (a2 == 0) ATT_TR4(v0, v1, v2, v3, vb, (2 * dp) * 32, (2 * dp) * 32 + 4352, (2 * dp + 1) * 32, (2 * dp + 1) * 32 + 4352);
                    else ATT_TR4(v0, v1, v2, v3, vb, 8704 + (2 * dp) * 32, 8704 + (2 * dp) * 32 + 4352, 8704 + (2 * dp + 1) * 32, 8704 + (2 * dp + 1) * 32 + 4352);
                    const bf16x8 vf0 = __builtin_shufflevector(v0, v1, 0, 1, 2, 3, 4, 5, 6, 7), vf1 = __builtin_shufflevector(v2, v3, 0, 1, 2, 3, 4, 5, 6, 7);
                    o[2 * dp] = __builtin_amdgcn_mfma_f32_16x16x32_bf16(pf, vf0, o[2 * dp], 0, 0, 0);
                    o[2 * dp + 1] = __builtin_amdgcn_mfma_f32_16x16x32_bf16(pf, vf1, o[2 * dp + 1], 0, 0, 0); } }
            }
            if (__any(carry > -104.0f)) { if (l == 0) flag[0] = (unsigned)(it + 1); }
            if (kb > 0) ATT_STOREKV(cur ^ 1);
            __syncthreads();
            if (flag[0] < (unsigned)(it + 1)) break;
            cur ^= 1; ++it;
        }
#undef ATT_LOADKV
#undef ATT_STOREKV
        __syncthreads();
#pragma unroll
        for (int dt = 0; dt < 8; ++dt)
#pragma unroll
            for (int rg = 0; rg < 4; ++rg) Os[(16 * w + 4 * l4 + rg) * 136 + 16 * dt + l15] = (bf16_t)f2bf(o[dt][rg]);
        __syncthreads();
        for (int i = 0; i < 4; ++i) { const int id = F.tid + 512 * i, row = id >> 4, ch = id & 15;
            *(u32x4*)(y0 + (size_t)(t0 + row) * 2048 + 1024 + h * 128 + ch * 8) = *(const LAS u32x4*)(Os + row * 136 + ch * 8); }
    }
#undef ATT_TR4
    __syncthreads();
}
__device__ __forceinline__ void ph_gates(ArgP ap, const Frame& F_) {
    ap = launder(ap); unsigned char* ws = ap->ws; const Frame F = relaunder(F_);
    GateSched S{(const char*)(ws + WS_XC), (const char*)(ws + WS_WGATE), F.G, F.bid};
    EpiPlain E{(bf16_t*)(ws + WS_GPRE), 2048, (size_t)256 * 2048, 256};
    pg8::gemm_phase(F.lds, S, E);
}
__device__ __forceinline__ void ph_scan(ArgP ap, const Frame& F_, const int pass) {
    ap = launder(ap); unsigned char* ws = ap->ws; const Frame F = relaunder(F_);
    const bf16_t* gpre = (const bf16_t*)(ws + WS_GPRE); const bf16_t* xc = (const bf16_t*)(ws + WS_XC); const bf16_t* proj = (const bf16_t*)(ws + WS_PROJ0);
    f32x2* SUB = (f32x2*)(ws + WS_SUB); f32x2* CH = (f32x2*)(ws + WS_CH); bf16_t* y0 = (bf16_t*)(ws + WS_Y0);
    LAS f32x2* Ls = (LAS f32x2*)F.lds;
    const int cg = F.tid & 127, sub = F.tid >> 7, ch0 = cg * 8, g = ch0 >> 7, chin = ch0 & 127;
    float ba[8], bx[8], spl[8];
    { const float* gab = INP(float, 7); const float* gxb = INP(float, 9); const float* lamp = INP(float, 10);
#pragma unroll
      for (int j = 0; j < 8; ++j) { ba[j] = gab[ch0 + j]; bx[j] = gxb[ch0 + j]; const float lam = lamp[ch0 + j]; spl[j] = fmaxf(-lam, 0.f) + log1pf(__expf(-fabsf(lam))); } }
    for (int u = F.bid; u < 256; u += F.G) {
        const int b = u >> 7, c = u & 127;
        float hst[8], Ast[8];
#pragma unroll
        for (int j = 0; j < 8; ++j) { hst[j] = 0.f; Ast[j] = 1.f; }
        __syncthreads();
        if (pass == 1) {
            { const int c2 = F.tid * 2; float h0 = 0.f, h1 = 0.f;
              for (int cc = 0; cc < c; ++cc) { const f32x4 s = *(const f32x4*)(CH + ((size_t)(b * 128 + cc) * 1024 + c2)); h0 = fmaf(s.x, h0, s.y); h1 = fmaf(s.z, h1, s.w); }
              ((LAS float*)Ls)[c2] = h0; ((LAS float*)Ls)[c2 + 1] = h1; }
            __syncthreads();
#pragma unroll
            for (int j = 0; j < 8; ++j) hst[j] = ((LAS float*)Ls)[ch0 + j];
            for (int s2 = 0; s2 < sub; ++s2) { const f32x2* sp2 = SUB + ((size_t)(b * 512 + c * 4 + s2) * 1024 + ch0);
#pragma unroll
                for (int j = 0; j < 8; ++j) { const f32x2 s = sp2[j]; hst[j] = fmaf(s.x, hst[j], s.y); } }
        }
        const int tbase = b * SEQ + c * 128 + sub * 32;
        for (int i0 = 0; i0 < 32; i0 += 4) {
            u32x4 rpa[4], rpx[4], rxv[4], rgr[4];
#pragma unroll
            for (int ii = 0; ii < 4; ++ii) { const size_t t = (size_t)(tbase + i0 + ii);
                rpa[ii] = *(const u32x4*)(gpre + t * 2048 + g * 256 + chin); rpx[ii] = *(const u32x4*)(gpre + t * 2048 + g * 256 + 128 + chin); rxv[ii] = *(const u32x4*)(xc + t * 1024 + ch0);
                if (pass == 1) rgr[ii] = *(const u32x4*)(proj + t * EV_IN + 1024 + ch0); }
#pragma unroll
            for (int ii = 0; ii < 4; ++ii) { const size_t t = (size_t)(tbase + i0 + ii);
                float pa[8], px[8], xv[8], gr[8], outv[8];
                unpack8(rpa[ii], pa); unpack8(rpx[ii], px); unpack8(rxv[ii], xv);
                if (pass == 1) unpack8(rgr[ii], gr);
#pragma unroll
                for (int j = 0; j < 8; ++j) {
                    const float r = sigmoidf_(pa[j] + ba[j]), ig = sigmoidf_(px[j] + bx[j]);
                    const float la = -8.0f * r * spl[j]; const float a = __expf(la);
                    const float mlt = __builtin_amdgcn_sqrtf(fmaxf(1.0f - a * a, 0.f));
                    const float uu = mlt * (ig * xv[j]);
                    hst[j] = fmaf(a, hst[j], uu); Ast[j] *= a;
                    if (pass == 1) outv[j] = hst[j] * gelu_tanh(gr[j]);
                }
                if (pass == 1) *(u32x4*)(y0 + t * 2048 + ch0) = pack8(outv);
            }
        }
        if (pass == 0) {
            f32x2* sp2 = SUB + ((size_t)(b * 512 + c * 4 + sub) * 1024 + ch0);
#pragma unroll
            for (int j = 0; j < 8; ++j) { f32x2 s; s.x = Ast[j]; s.y = hst[j]; sp2[j] = s; Ls[sub * 1024 + ch0 + j] = s; }
            __syncthreads();
            if (sub == 0) {
#pragma unroll
                for (int j = 0; j < 8; ++j) { float A = 1.f, Hh = 0.f;
#pragma unroll
                    for (int s2 = 0; s2 < 4; ++s2) { const f32x2 s = Ls[s2 * 1024 + ch0 + j]; Hh = fmaf(s.x, Hh, s.y); A *= s.x; }
                    f32x2 o; o.x = A; o.y = Hh; CH[(size_t)(b * 128 + c) * 1024 + ch0 + j] = o; }
            }
        }
    }
    __syncthreads();
}
__device__ __forceinline__ void ph_outproj0(ArgP ap, const Frame& F_) {
    ap = launder(ap); unsigned char* ws = ap->ws; const Frame F = relaunder(F_);
    pg8::DenseSched<128, 8, 2048, 2048, 2048> S{(const char*)(ws + WS_Y0), (const char*)(ws + WS_WEVO), F.G, F.bid};
    EpiResid E{INP(float, 0), ap->out, 0, (float*)(ws + WS_ROWSS)};
    pg8::gemm_phase(F.lds, S, E);
}
__device__ __forceinline__ void ph_l1_inproj(ArgP ap, const Frame& F_, const int b) {
    ap = launder(ap); unsigned char* ws = ap->ws; const Frame F = relaunder(F_);
    const char* Hbb = (const char*)(ws + WS_H) + (size_t)b * SEQ * D * 2; const char* wod = (const char*)(ws + WS_WOD); const float* rot = (const float*)(ws + WS_ROT);
    { pg8::DenseSched<64, 8, 2048, 2048, 2048> S{Hbb, wod, F.G, F.bid};
      EpiRotary E{(bf16_t*)(ws + WS_QCAT) + 256, 512, (size_t)256 * 512, (size_t)16384 * 512, rot, b * SEQ, 1.0f};
      pg8::gemm_phase(F.lds, S, E); }
    { pg8::DenseSched<64, 8, 2048, 2048, 2048> S{Hbb, wod + (size_t)2048 * 2048 * 2, F.G, F.bid};
      EpiRotaryT E{(bf16_t*)(ws + WS_KB), (bf16_t*)(ws + WS_KDT), rot, b * SEQ, 0.0625f};
      pg8::gemm_phase(F.lds, S, E); }
    { VtSched S{wod + (size_t)4096 * 2048 * 2, Hbb, F.G, F.bid};
      EpiUnitPtr E{(bf16_t*)(ws + WS_VRCAT), 512};
      pg8::gemm_phase(F.lds, S, E); }
}
__device__ __forceinline__ void ph_l1_kv(ArgP ap, const Frame& F_) {
    ap = launder(ap); unsigned char* ws = ap->ws; const Frame F = relaunder(F_);
    KvSched S{(const char*)(ws + WS_VRCAT), (const char*)(ws + WS_KDT), F.G, F.bid};
    EpiUnitPtr E{(bf16_t*)(ws + WS_VRCAT), 512};
    pg8::gemm_phase(F.lds, S, E);
}
__device__ __forceinline__ void ph_l1_rscan(ArgP ap, const Frame& F_) {
    ap = launder(ap); unsigned char* ws = ap->ws; const Frame F = relaunder(F_);
    bf16_t* vrcat = (bf16_t*)(ws + WS_VRCAT);
    for (int v = F.bid * 512 + F.tid; v < 131072; v += F.G * 512) {
        const int h = v >> 14, rem = v & 16383, e = rem >> 5, d8 = rem & 31;
        const float cd = __builtin_amdgcn_exp2f(256.0f * __log2f(1.0f - exp2f(-5.0f - (float)h)));
        bf16_t* p = vrcat + ((size_t)h * 64 * 512 + e) * 512 + 256 + d8 * 8;
        float R[8];
#pragma unroll
        for (int j = 0; j < 8; ++j) R[j] = 0.f;
        for (int n0 = 0; n0 < 64; n0 += 8) {
            u32x4 raw[8];
#pragma unroll
            for (int j2 = 0; j2 < 8; ++j2) raw[j2] = *(const u32x4*)(p + (size_t)(n0 + j2) * 512 * 512);
#pragma unroll
            for (int j2 = 0; j2 < 8; ++j2) { float kv[8]; unpack8(raw[j2], kv);
                *(u32x4*)(p + (size_t)(n0 + j2) * 512 * 512) = pack8(R);
#pragma unroll
                for (int j = 0; j < 8; ++j) R[j] = fmaf(cd, R[j], kv[j]); }
        }
    }
    { bf16_t* qcat = (bf16_t*)(ws + WS_QCAT);
      SpSched S{(const char*)qcat, (const char*)(ws + WS_KB), F.G, F.bid};
      EpiSprime E{qcat};
      pg8::gemm_phase(F.lds, S, E); }
}
__device__ __forceinline__ void ph_l1_y(ArgP ap, const Frame& F_) {
    ap = launder(ap); unsigned char* ws = ap->ws; const Frame F = relaunder(F_);
    YSched S{(const char*)(ws + WS_QCAT), (const char*)(ws + WS_VRCAT), F.G, F.bid};
    EpiY E{(bf16_t*)(ws + WS_YB), (f32x2*)(ws + WS_STATS)};
    pg8::gemm_phase(F.lds, S, E);
}
__device__ __forceinline__ void ph_l1_gnorm(ArgP ap, const Frame& F_, const int b) {
    ap = launder(ap); unsigned char* ws = ap->ws; const Frame F = relaunder(F_);
    const char* Hbb = (const char*)(ws + WS_H) + (size_t)b * SEQ * D * 2; const char* wod = (const char*)(ws + WS_WOD);
    pg8::DenseSched<64, 16, 2048, 2048, 2048> S{Hbb, wod + (size_t)8192 * 2048 * 2, F.G, F.bid};
    EpiGnorm E{(bf16_t*)(ws + WS_YB), (const f32x2*)(ws + WS_STATS), INP(float, 14)};
    pg8::gemm_phase(F.lds, S, E);
}
__device__ __forceinline__ void ph_l1_out(ArgP ap, const Frame& F_, const int b) {
    ap = launder(ap); unsigned char* ws = ap->ws; const Frame F = relaunder(F_);
    pg8::DenseSched<64, 8, 4096, 4096, 4096> S{(const char*)(ws + WS_YB), (const char*)(ws + WS_WODO), F.G, F.bid};
    EpiResid E{ap->out, ap->out, b * SEQ, (float*)(ws + WS_ROWSS)};
    pg8::gemm_phase(F.lds, S, E);
}
typedef float f32x16 __attribute__((ext_vector_type(16)));
__device__ __forceinline__ void ph_router(ArgP ap, const Frame& F_, const int layer) {
    ap = launder(ap); unsigned char* ws = ap->ws; const Frame F = relaunder(F_);
    if (layer == 1) convert_experts(F, INP(float, 21) + (size_t)32 * 2048 * 512, INP(float, 22) + (size_t)32 * 2048 * 512, INP(float, 23) + (size_t)32 * 512 * 2048, ws);
    const float* xres = ap->out; bf16_t* Hb = (bf16_t*)(ws + WS_H);
    int* CNT = (int*)(ws + SM_CNT); int* ASGE = (int*)(ws + SM_ASGE); int* ASGR = (int*)(ws + SM_ASGR); float* ASGW = (float*)(ws + SM_ASGW);
    const float* gain = INP(float, 16) + layer * D; const float* wgp = INP(float, 17) + (size_t)layer * D * 4; const float* wep = INP(float, 19) + (size_t)layer * D * 32;
    const float* bgp = INP(float, 18) + layer * 4; const float* bep = INP(float, 20) + layer * 32;
    LAS float* xs = (LAS float*)F.lds;
    LAS float* wc = xs + 128 * 65;
    LAS float* pe = wc + 64 * 40;
    LAS float* pg = pe + 2 * 128 * 33;
    LAS float* lg = pg + 4 * 128 * 5;
    LAS float* rs = lg + 128 * 36;
    LAS int* el = (LAS int*)(rs + 128);
    LAS int* wcnt = el + 256;
    const int w = F.wave, l = F.lane, mt = w & 3, kh = w >> 2, l31 = l & 31, l5 = l >> 5;
    const int tl = F.tid & 127, kq = F.tid >> 7;
    const float* rowss = (const float*)(ws + WS_ROWSS);
    for (int tile = F.bid; tile < 256; tile += F.G) {
        const int tok0 = tile * 128;
        f32x16 acc;
#pragma unroll
        for (int i2 = 0; i2 < 16; ++i2) acc[i2] = 0.f;
        float g4[4] = {0.f, 0.f, 0.f, 0.f};
        __syncthreads();
        if (F.tid < 128) { const f32x4* p = (const f32x4*)(rowss + (size_t)(tok0 + F.tid) * 32); float sq = 0.f;
#pragma unroll
            for (int q = 0; q < 8; ++q) { const f32x4 v = p[q]; sq += (v.x + v.y) + (v.z + v.w); }
            rs[F.tid] = 1.0f / sqrtf(sq * (1.0f / D) + EPS); }
        f32x4 xr[4], gch;
        const int srow = F.tid >> 4, sc4 = (F.tid & 15) * 4;
#pragma unroll
        for (int i2 = 0; i2 < 4; ++i2) xr[i2] = *(const f32x4*)(xres + (size_t)(tok0 + srow + 32 * i2) * D + sc4);
        gch = *(const f32x4*)(gain + sc4);
        float wpre[5];
#pragma unroll
        for (int i2 = 0; i2 < 5; ++i2) { const int idx = F.tid + 512 * i2; wpre[i2] = 0.f; if (idx < 64 * 36) { const int k = idx / 36, o = idx % 36;
            wpre[i2] = gain[k] * (o < 4 ? wgp[k * 4 + o] : wep[k * 32 + (o - 4)]); } }
        __syncthreads();
        float rsr[4];
#pragma unroll
        for (int i2 = 0; i2 < 4; ++i2) rsr[i2] = rs[srow + 32 * i2];
        for (int kc = 0; kc < 32; ++kc) {
            __syncthreads();
#pragma unroll
            for (int i2 = 0; i2 < 4; ++i2) { LAS float* d = xs + (srow + 32 * i2) * 65 + sc4; d[0] = xr[i2].x; d[1] = xr[i2].y; d[2] = xr[i2].z; d[3] = xr[i2].w;
                u32x2 hw; hw.x = pk2(xr[i2].x * rsr[i2] * gch.x, xr[i2].y * rsr[i2] * gch.y); hw.y = pk2(xr[i2].z * rsr[i2] * gch.z, xr[i2].w * rsr[i2] * gch.w);
                *(u32x2*)(Hb + (size_t)(tok0 + srow + 32 * i2) * D + kc * 64 + sc4) = hw; }
#pragma unroll
            for (int i2 = 0; i2 < 5; ++i2) { const int idx = F.tid + 512 * i2; if (idx < 64 * 36) wc[(idx / 36) * 40 + (idx % 36)] = wpre[i2]; }
            __syncthreads();
            if (kc + 1 < 32) {
#pragma unroll
                for (int i2 = 0; i2 < 4; ++i2) xr[i2] = *(const f32x4*)(xres + (size_t)(tok0 + srow + 32 * i2) * D + (kc + 1) * 64 + sc4);
                gch = *(const f32x4*)(gain + (kc + 1) * 64 + sc4);
#pragma unroll
                for (int i2 = 0; i2 < 5; ++i2) { const int idx = F.tid + 512 * i2; if (idx < 64 * 36) { const int k = idx / 36, o = idx % 36, kk = (kc + 1) * 64 + k;
                    wpre[i2] = gain[kk] * (o < 4 ? wgp[kk * 4 + o] : wep[kk * 32 + (o - 4)]); } } }
#pragma unroll
            for (int s2 = 0; s2 < 16; ++s2) { const int k = 32 * kh + 2 * s2 + l5;
                acc = __builtin_amdgcn_mfma_f32_32x32x2f32(xs[(32 * mt + l31) * 65 + k], wc[k * 40 + 4 + l31], acc, 0, 0, 0); }
#pragma unroll
            for (int k2 = 0; k2 < 16; ++k2) { const int k = 16 * kq + k2; const float xv = xs[tl * 65 + k]; const f32x4 wv = *(const LAS f32x4*)(wc + k * 40);
                g4[0] = fmaf(xv, wv.x, g4[0]); g4[1] = fmaf(xv, wv.y, g4[1]); g4[2] = fmaf(xv, wv.z, g4[2]); g4[3] = fmaf(xv, wv.w, g4[3]); }
        }
#pragma unroll
        for (int rg = 0; rg < 16; ++rg) pe[(kh * 128 + 32 * mt + (rg & 3) + 8 * (rg >> 2) + 4 * l5) * 33 + l31] = acc[rg];
        { LAS float* p = pg + (kq * 128 + tl) * 5; p[0] = g4[0]; p[1] = g4[1]; p[2] = g4[2]; p[3] = g4[3]; }
        __syncthreads();
        for (int idx = F.tid; idx < 128 * 36; idx += 512) { const int t = idx / 36, o = idx % 36; float v;
            if (o < 4) v = (pg[(0 * 128 + t) * 5 + o] + pg[(1 * 128 + t) * 5 + o]) + (pg[(2 * 128 + t) * 5 + o] + pg[(3 * 128 + t) * 5 + o]);
            else v = pe[t * 33 + (o - 4)] + pe[(128 + t) * 33 + (o - 4)];
            lg[idx] = v * rs[t] + (o < 4 ? bgp[o] : bep[o - 4]); }
        __syncthreads();
        if (F.tid < 128) {
            const LAS float* q = lg + F.tid * 36;
            int gi = 0; float gm = q[0];
#pragma unroll
            for (int j2 = 1; j2 < 4; ++j2) if (q[j2] > gm) { gm = q[j2]; gi = j2; }
            float gs = 0.f;
#pragma unroll
            for (int j2 = 0; j2 < 4; ++j2) gs += __expf(q[j2] - gm);
            const float gwt = 1.0f / gs;
            const LAS float* eq = q + 4 + gi * 8;
            int j0 = 0; float m0 = eq[0];
#pragma unroll
            for (int j2 = 1; j2 < 8; ++j2) if (eq[j2] > m0) { m0 = eq[j2]; j0 = j2; }
            int j1 = -1; float m1v = -3.0e38f;
#pragma unroll
            for (int j2 = 0; j2 < 8; ++j2) if (j2 != j0 && eq[j2] > m1v) { m1v = eq[j2]; j1 = j2; }
            const float p1 = __expf(m1v - m0);
            const float w0 = gwt / (1.0f + p1), w1 = gwt * p1 / (1.0f + p1);
            const int tok = tok0 + F.tid;
            el[2 * F.tid] = gi * 8 + j0; el[2 * F.tid + 1] = gi * 8 + j1;
            ASGE[2 * tok] = gi * 8 + j0; ASGE[2 * tok + 1] = gi * 8 + j1; ASGW[2 * tok] = w0; ASGW[2 * tok + 1] = w1;
        }
        __syncthreads();
        int myrank = 0, mye = 0;
        if (F.tid < 256) { mye = el[F.tid];
            for (int e = 0; e < 32; ++e) { const unsigned long long m = __ballot(mye == e); if (mye == e) myrank = __popcll(m & ((1ull << l) - 1ull)); if (l == 0) wcnt[w * 32 + e] = __popcll(m); } }
        __syncthreads();
        if (F.tid < 256) { int off = 0; for (int w2 = 0; w2 < w; ++w2) off += wcnt[w2 * 32 + mye]; ASGR[2 * tok0 + F.tid] = off + myrank; }
        if (F.tid < 32) CNT[tile * 32 + F.tid] = wcnt[F.tid] + wcnt[32 + F.tid] + wcnt[64 + F.tid] + wcnt[96 + F.tid];
    }
    __syncthreads();
}
__device__ __forceinline__ void ph_dispatch(ArgP ap, const Frame& F_) {
    ap = launder(ap); unsigned char* ws = ap->ws; const Frame F = relaunder(F_);
    int* CNT = (int*)(ws + SM_CNT); int* TT = (int*)(ws + SM_TT); int* ASGE = (int*)(ws + SM_ASGE); int* ASGR = (int*)(ws + SM_ASGR); int* DEST = (int*)(ws + SM_DEST); int* ROWTOK = (int*)(ws + SM_ROWTOK);
    LAS int* cl = (LAS int*)F.lds;
    LAS int* tot = cl + 256 * 32;
    LAS int* tstart = tot + 32;
    LAS int* base = tstart + 32;
    __syncthreads();
    for (int idx = F.tid; idx < 256 * 32; idx += 512) cl[idx] = CNT[idx];
    __syncthreads();
    if (F.tid < 32) { int s = 0; for (int w2 = 0; w2 < 256; ++w2) s += cl[w2 * 32 + F.tid]; tot[F.tid] = s; }
    __syncthreads();
    if (F.tid == 0) { int acc2 = 0; for (int e = 0; e < 32; ++e) { tstart[e] = acc2; acc2 += (tot[e] + 255) >> 8; }
        if (F.bid == 0) { TT[0] = acc2; for (int e = 0; e < 32; ++e) { const int n = (tot[e] + 255) >> 8; for (int i = 0; i < n; ++i) TT[1 + tstart[e] + i] = e; } } }
    __syncthreads();
    for (int tile = F.bid; tile < 256; tile += F.G) {
        if (F.tid < 32) { int s = 0; for (int w2 = 0; w2 < tile; ++w2) s += cl[w2 * 32 + F.tid]; base[F.tid] = s; }
        __syncthreads();
        if (F.tid < 256) { const int a = 2 * tile * 128 + F.tid; const int e = ASGE[a]; const int pos = tstart[e] * 256 + base[e] + ASGR[a]; DEST[a] = pos; ROWTOK[pos] = a >> 1; }
        __syncthreads();
    }
    for (int e = F.bid; e < 32; e += F.G) { const int n = (tot[e] + 255) >> 8; for (int p = tot[e] + F.tid; p < n * 256; p += 512) ROWTOK[tstart[e] * 256 + p] = 0; }
    __syncthreads();
}
__device__ __forceinline__ void ph_moe1(ArgP ap, const Frame& F_) {
    ap = launder(ap); unsigned char* ws = ap->ws; const Frame F = relaunder(F_);
    const int* TT = (const int*)(ws + SM_TT);
    LAS int* tt = (LAS int*)(F.lds + LDS_TT);
    __syncthreads();
    for (int idx = F.tid; idx < 1 + NRT_MAX; idx += 512) tt[idx] = TT[idx];
    __syncthreads();
    Moe1Sched S{(const char*)(ws + WS_H), (const char*)(ws + WS_WGU), (const int*)(ws + SM_ROWTOK), tt, F.G, F.bid};
    EpiSwiGLU E{(bf16_t*)(ws + WS_HID)};
    pg8::gemm_phase(F.lds, S, E);
}
__device__ __forceinline__ void ph_moe2(ArgP ap, const Frame& F_) {
    ap = launder(ap); unsigned char* ws = ap->ws; const Frame F = relaunder(F_);
    const int* TT = (const int*)(ws + SM_TT);
    LAS int* tt = (LAS int*)(F.lds + LDS_TT);
    __syncthreads();
    for (int idx = F.tid; idx < 1 + NRT_MAX; idx += 512) tt[idx] = TT[idx];
    __syncthreads();
    Moe2Sched S{(const char*)(ws + WS_HID), (const char*)(ws + WS_WD), tt, F.G, F.bid};
    EpiPlain E{(bf16_t*)(ws + WS_YBUF), 2048, (size_t)256 * 2048, 256};
    pg8::gemm_phase(F.lds, S, E);
}
__device__ __forceinline__ void ph_combine(ArgP ap, const Frame& F_, const int layer) {
    ap = launder(ap); unsigned char* ws = ap->ws; const Frame F = relaunder(F_);
    const bf16_t* yb = (const bf16_t*)(ws + WS_YBUF); float* xres = ap->out; bf16_t* Hb = (bf16_t*)(ws + WS_H);
    const int* DEST = (const int*)(ws + SM_DEST); const float* ASGW = (const float*)(ws + SM_ASGW);
    const float* gain = layer == 0 ? INP(float, 12) : INP(float, 24);
    for (int m = F.bid * 8 + F.wave; m < T; m += F.G * 8) {
        const int d0 = DEST[2 * m], d1 = DEST[2 * m + 1]; const float w0 = ASGW[2 * m], w1 = ASGW[2 * m + 1];
        f32x4* xr = (f32x4*)(xres + (size_t)m * D) + F.lane; const f32x4* gr = (const f32x4*)gain + F.lane;
        const u32x2* y0p = (const u32x2*)(yb + (size_t)d0 * D) + F.lane; const u32x2* y1p = (const u32x2*)(yb + (size_t)d1 * D) + F.lane;
        f32x4 v[8]; float s = 0.f;
#pragma unroll
        for (int j = 0; j < 8; ++j) { const f32x4 xv = xr[64 * j]; const u32x2 a = y0p[64 * j], c = y1p[64 * j];
            v[j].x = xv.x + w0 * bf_lo(a.x) + w1 * bf_lo(c.x); v[j].y = xv.y + w0 * bf_hi(a.x) + w1 * bf_hi(c.x);
            v[j].z = xv.z + w0 * bf_lo(a.y) + w1 * bf_lo(c.y); v[j].w = xv.w + w0 * bf_hi(a.y) + w1 * bf_hi(c.y);
            s += (v[j].x * v[j].x + v[j].y * v[j].y) + (v[j].z * v[j].z + v[j].w * v[j].w); }
        const float rstd = 1.0f / sqrtf(wave_sum(s) * (1.0f / D) + EPS);
        if (layer == 0) {
            u32x2* o8 = (u32x2*)(Hb + (size_t)m * D) + F.lane;
#pragma unroll
            for (int j = 0; j < 8; ++j) { xr[64 * j] = v[j]; const f32x4 g = gr[64 * j]; u32x2 w; w.x = pk2(v[j].x * rstd * g.x, v[j].y * rstd * g.y); w.y = pk2(v[j].z * rstd * g.z, v[j].w * rstd * g.w); o8[64 * j] = w; }
        } else {
#pragma unroll
            for (int j = 0; j < 8; ++j) { const f32x4 g = gr[64 * j]; f32x4 o; o.x = v[j].x * rstd * g.x; o.y = v[j].y * rstd * g.y; o.z = v[j].z * rstd * g.z; o.w = v[j].w * rstd * g.w; xr[64 * j] = o; }
        }
    }
}

#ifndef PH_MASK
#define PH_MASK 0xffffffffull
#endif
#define SITE(s) ((PH_MASK >> (s)) & 1ull)
__global__ void __launch_bounds__(512, 2) mk_fwd(Args args) {
    extern __shared__ __attribute__((aligned(16))) unsigned char lds_raw[];
    ArgP ap = (ArgP)__builtin_amdgcn_kernarg_segment_ptr();
    Frame F;
    F.lds = (LAS unsigned char*)lds_raw;
    F.tid = threadIdx.x; F.lane = F.tid & 63; F.wave = __builtin_amdgcn_readfirstlane(F.tid >> 6); F.G = gridDim.x; F.bid = blockIdx.x;
    volatile LAS unsigned* MISC = (volatile LAS unsigned*)(F.lds + LDS_MISC);
    if (F.tid < 64) MISC[F.tid] = 0u;
    __syncthreads();
    const int lo = ap->ph_lo, hi = ap->ph_hi;
    XcdBarrier bar = xcd_barrier_post((unsigned*)(ap->ws + WS_CTL) + CW_BAR + ap->li * XCD_BAR_WORDS, MISC + 8);
#define IN(k) (SITE(k) && lo <= (k) && (k) < hi)
#define SEAM(k) do { if ((k) + 1 < hi) xcd_barrier(bar); } while (0)
#ifndef REP_MASK
#define REP_MASK 0ull
#endif
#define RUN(k, call) if (IN(k)) { call; if constexpr (((REP_MASK >> (k)) & 1ull) != 0ull) { xcd_barrier(bar); call; } SEAM(k); }
    RUN(0, ph_prologue(ap, F))
    RUN(1, ph_inproj0(ap, F))
    RUN(2, ph_conv_attn(ap, F))
    RUN(3, ph_gates(ap, F))
    RUN(4, ph_scan(ap, F, 0))
    RUN(5, ph_scan(ap, F, 1))
    RUN(6, ph_outproj0(ap, F))
#define MOE_HALF(layer, p0) \
    RUN((p0) + 0, ph_router(ap, F, layer)) \
    RUN((p0) + 1, ph_dispatch(ap, F)) \
    RUN((p0) + 2, ph_moe1(ap, F)) \
    RUN((p0) + 3, ph_moe2(ap, F)) \
    RUN((p0) + 4, ph_combine(ap, F, layer))
#define L1_MIXER(b, p0) \
    RUN((p0) + 0, ph_l1_inproj(ap, F, b)) \
    RUN((p0) + 1, ph_l1_kv(ap, F)) \
    RUN((p0) + 2, ph_l1_rscan(ap, F)) \
    RUN((p0) + 3, ph_l1_y(ap, F)) \
    RUN((p0) + 4, ph_l1_gnorm(ap, F, b)) \
    RUN((p0) + 5, ph_l1_out(ap, F, b))
    MOE_HALF(0, 7)
    L1_MIXER(0, 12)
    L1_MIXER(1, 18)
    MOE_HALF(1, 24)
#ifdef XBAR_PROBE
    for (int i = 0; i < XBAR_PROBE; ++i) xcd_barrier(bar);
#endif
#undef MOE_HALF
#undef L1_MIXER
#undef IN
#undef SEAM
}

constexpr int N_PHASES = 29;
#ifndef MK_PER_PHASE
#define MK_PER_PHASE 0
#endif
extern "C" void kernel_launch(void* const* d_in, const int* in_sizes, int n_in, void* d_out, int out_size, void* d_ws, size_t ws_size, hipStream_t stream) {
    static int grid = 0;
    if (grid == 0) {
        if (n_in != 25 || out_size != T * D || ws_size < WS_END) { fprintf(stderr, "kernel_launch: unexpected shapes (n_in %d out %d ws %zu)\n", n_in, out_size, ws_size); grid = -1; return; }
        int dev = 0, cus = 0, per_cu = 0;
        if (hipGetDevice(&dev) != hipSuccess || hipDeviceGetAttribute(&cus, hipDeviceAttributeMultiprocessorCount, dev) != hipSuccess) { grid = -1; return; }
        if (hipFuncSetAttribute((const void*)mk_fwd, hipFuncAttributeMaxDynamicSharedMemorySize, LDS_BYTES) != hipSuccess) { fprintf(stderr, "kernel_launch: hipFuncSetAttribute failed\n"); grid = -1; return; }
        if (hipOccupancyMaxActiveBlocksPerMultiprocessor(&per_cu, (const void*)mk_fwd, 512, LDS_BYTES) != hipSuccess || per_cu < 1) fprintf(stderr, "kernel_launch: occupancy query reports %d\n", per_cu);
        (void)hipGetLastError();
        grid = cus;
    }
    if (grid < 0) return;
    (void)hipMemsetAsync((char*)d_ws + WS_CTL, 0, CTL_ZERO_BYTES, stream);
    Args a; memset(&a, 0, sizeof(a));
    for (int i = 0; i < 25; ++i) a.in[i] = d_in[i];
    a.out = (float*)d_out; a.ws = (unsigned char*)d_ws;
#if MK_PER_PHASE
    for (int p = 0; p < N_PHASES; ++p) { a.ph_lo = p; a.ph_hi = p + 1; a.li = 0; hipLaunchKernelGGL(mk_fwd, dim3(grid), dim3(512), LDS_BYTES, stream, a); }
#else
    a.ph_lo = 0; a.ph_hi = N_PHASES; a.li = 0;
    hipLaunchKernelGGL(mk_fwd, dim3(grid), dim3(512), LDS_BYTES, stream, a);
#endif
}
```
